# Optimizing an MI355X kernel written in HIP

```python
import jax, jax.numpy as jnp
from jax import lax
import numpy as np

D_MODEL = 1024
BATCH = 8
SEQ = 4096
DEPTH = 4

CTX_LEN = 256
GRID_W = 64

POOL_WIDTH = D_MODEL // 4
POOL_WINDOWS = (2, 4, 8, 16)
POOL_GROUP = POOL_WIDTH // len(POOL_WINDOWS)
SGU_WIDTH = D_MODEL // 4
SGU_HEADS = 4
SGU_HEAD_DIM = SGU_WIDTH // SGU_HEADS
SGU_CHUNK = 128
ATTN_WIDTH = D_MODEL - POOL_WIDTH - SGU_WIDTH
HEAD_DIM = 64
N_HEADS = ATTN_WIDTH // HEAD_DIM
N_KV_HEADS = 2
KV_GROUP = N_HEADS // N_KV_HEADS
KV_WIDTH = N_KV_HEADS * HEAD_DIM
Q_BLOCK = 128
ROPE_THETA = 10000.0
ROPE_AXIS_FREQS = HEAD_DIM // 4
MIX_WIDTH = POOL_WIDTH + SGU_WIDTH + ATTN_WIDTH

OFF_POOL = 0
OFF_U = OFF_POOL + POOL_WIDTH
OFF_V = OFF_U + SGU_WIDTH
OFF_Q = OFF_V + SGU_WIDTH
OFF_K = OFF_Q + ATTN_WIDTH
OFF_VAL = OFF_K + KV_WIDTH
IN_WIDTH = OFF_VAL + KV_WIDTH

N_EXPERTS = 16
EXPERT_FF = D_MODEL
EC_CAPACITY_FACTOR = 2

DN_ALPHA = (2 * DEPTH) ** 0.25
DN_BETA = (8 * DEPTH) ** -0.25
LN_EPS = 1e-6

kernel_name = "hybrid_pool_sgu_gqa_ec_moe_deepnorm"


def layer_norm(x, g=None, b=None):
    xf = x.astype(jnp.float32)
    mu = jnp.mean(xf, axis=-1, keepdims=True)
    var = jnp.mean(jnp.square(xf - mu), axis=-1, keepdims=True)
    y = (xf - mu) * lax.rsqrt(var + LN_EPS)
    if g is not None:
        y = y * g.astype(jnp.float32) + b.astype(jnp.float32)
    return y.astype(x.dtype)


def rms_norm(x, g):
    xf = x.astype(jnp.float32)
    y = xf * lax.rsqrt(jnp.mean(jnp.square(xf), axis=-1, keepdims=True) + LN_EPS)
    return (y * g.astype(jnp.float32)).astype(x.dtype)


def modulation(cond, w_mod, b_mod):
    m = jax.nn.silu(cond) @ w_mod + b_mod
    return jnp.split(m[:, None, :], 6, axis=-1)


def modulate(x, shift, scale):
    return layer_norm(x) * (1 + scale) + shift


def axial_rope(n):
    rows = n // GRID_W
    r = jnp.repeat(jnp.arange(rows, dtype=jnp.float32), GRID_W)
    col = jnp.tile(jnp.arange(GRID_W, dtype=jnp.float32), rows)
    inv = ROPE_THETA ** (-jnp.arange(ROPE_AXIS_FREQS, dtype=jnp.float32) / ROPE_AXIS_FREQS)
    ang = jnp.concatenate([r[:, None] * inv, col[:, None] * inv], axis=-1)
    return jnp.cos(ang), jnp.sin(ang)


def apply_rope(x, cos, sin):
    half = HEAD_DIM // 2
    xf = x.astype(jnp.float32)
    x1, x2 = xf[..., :half], xf[..., half:]
    cs, sn = cos[None, :, None, :], sin[None, :, None, :]
    return jnp.concatenate([x1 * cs - x2 * sn, x2 * cs + x1 * sn], axis=-1).astype(x.dtype)


def heads(z, off, n):
    return z[..., off:off + n * HEAD_DIM].reshape(z.shape[0], z.shape[1], n, HEAD_DIM)


def multiscale_pool(p, w, scale):
    L = p.shape[1]
    t = jnp.arange(L)
    outs = []
    for g, win in enumerate(POOL_WINDOWS):
        pg = p[..., g * POOL_GROUP:(g + 1) * POOL_GROUP].astype(jnp.float32)
        cs = jnp.concatenate([jnp.zeros_like(pg[:, :1]), jnp.cumsum(pg, axis=1)], axis=1)
        lo = jnp.clip(t - win // 2, 0, L)
        hi = jnp.clip(t + win // 2, 0, L)
        mean = (cs[:, hi] - cs[:, lo]) / (hi - lo).astype(jnp.float32)[None, :, None]
        outs.append((mean - pg).astype(p.dtype) @ w[g])
    return jnp.concatenate(outs, axis=-1) * scale


def spatial_gating(u, v, g, w_s, b_s):
    B, L, _ = u.shape
    shp = (B, L // SGU_CHUNK, SGU_CHUNK, SGU_HEADS, SGU_HEAD_DIM)
    uh = jax.nn.gelu(u).reshape(shp)
    vh = layer_norm(jax.nn.gelu(v).reshape(shp)) * g
    mixed = jnp.einsum('hpq,bcqhd->bcphd', w_s, vh) + b_s.T[:, :, None]
    return (uh * mixed).reshape(B, L, SGU_WIDTH)


def block_attention(q, k, v):
    B, Lq = q.shape[0], q.shape[1]
    nb = Lq // Q_BLOCK
    qb = q.reshape(B, nb, Q_BLOCK, N_KV_HEADS, KV_GROUP, HEAD_DIM).transpose(1, 0, 2, 3, 4, 5)
    scale = HEAD_DIM ** -0.5

    def one_block(qi):
        s = jnp.einsum('bqkgd,bskd->bkgqs', qi, k).astype(jnp.float32) * scale
        p = jax.nn.softmax(s, axis=-1).astype(v.dtype)
        return jnp.einsum('bkgqs,bskd->bqkgd', p, v)

    o = lax.map(one_block, qb)
    return o.transpose(1, 0, 2, 3, 4, 5).reshape(B, Lq, N_HEADS * HEAD_DIM)


def mixer_output(z, attn, pool_w, pool_scale, sgu_g, sgu_w, sgu_b, w_out):
    pool = multiscale_pool(z[..., OFF_POOL:OFF_U], pool_w, pool_scale)
    sgu = spatial_gating(z[..., OFF_U:OFF_V], z[..., OFF_V:OFF_Q], sgu_g, sgu_w, sgu_b)
    return jnp.concatenate([pool, sgu, attn], axis=-1) @ w_out


def expert_choice_moe(h, w_router, w1, w3, w2):
    B, L, D = h.shape
    cap = EC_CAPACITY_FACTOR * L // N_EXPERTS
    aff = jax.nn.softmax((h @ w_router).astype(jnp.float32), axis=-1)
    gate, idx = lax.top_k(jnp.swapaxes(aff, 1, 2), cap)
    xg = jax.vmap(lambda hb, ib: hb[ib])(h, idx)
    hid = jax.nn.silu(jnp.einsum('becd,edf->becf', xg, w1)) * jnp.einsum('becd,edf->becf', xg, w3)
    y = jnp.einsum('becf,efd->becd', hid, w2) * gate[..., None].astype(h.dtype)
    return jax.vmap(lambda ib, yb: jnp.zeros((L, D), yb.dtype).at[ib.reshape(-1)].add(yb.reshape(-1, D)))(idx, y)


def setup_inputs(seed: int = 0) -> dict:
    key = jax.random.key(seed)
    ks = jax.random.split(key, 24)
    f32 = jnp.float32

    def nrm(k, shape, std):
        return jax.random.normal(k, shape, f32) * std

    w_in = nrm(ks[6], (DEPTH, D_MODEL, IN_WIDTH), D_MODEL ** -0.5)
    w_in = w_in.at[:, :, OFF_VAL:].multiply(DN_BETA)
    return {
        "x": nrm(ks[0], (BATCH, SEQ, D_MODEL), 1.0),
        "c": nrm(ks[1], (BATCH, D_MODEL), 1.0),
        "ctx": nrm(ks[2], (BATCH, CTX_LEN, D_MODEL), 1.0),
        "c_ctx": nrm(ks[3], (D_MODEL,), 1.0),
        "w_mod": nrm(ks[4], (DEPTH, D_MODEL, 6 * D_MODEL), 0.5 * D_MODEL ** -0.5),
        "b_mod": nrm(ks[5], (DEPTH, 6 * D_MODEL), 0.02),
        "w_in": w_in,
        "pool_w": nrm(ks[7], (DEPTH, len(POOL_WINDOWS), POOL_GROUP, POOL_GROUP), POOL_GROUP ** -0.5),
        "pool_scale": 1.0 + nrm(ks[8], (DEPTH, POOL_WIDTH), 0.02),
        "sgu_g": 1.0 + nrm(ks[9], (DEPTH, SGU_HEADS, SGU_HEAD_DIM), 0.02),
        "sgu_w": nrm(ks[10], (DEPTH, SGU_HEADS, SGU_CHUNK, SGU_CHUNK), 0.5 * SGU_CHUNK ** -0.5),
        "sgu_b": 1.0 + nrm(ks[11], (DEPTH, SGU_HEADS, SGU_CHUNK), 0.02),
        "q_g": 1.0 + nrm(ks[12], (DEPTH, HEAD_DIM), 0.02),
        "k_g": 1.0 + nrm(ks[13], (DEPTH, HEAD_DIM), 0.02),
        "w_out": nrm(ks[14], (DEPTH, MIX_WIDTH, D_MODEL), DN_BETA * MIX_WIDTH ** -0.5),
        "ln1_g": 1.0 + nrm(ks[15], (DEPTH, D_MODEL), 0.02),
        "ln1_b": nrm(ks[16], (DEPTH, D_MODEL), 0.02),
        "w_router": nrm(ks[17], (DEPTH, D_MODEL, N_EXPERTS), D_MODEL ** -0.5),
        "w1": nrm(ks[18], (DEPTH, N_EXPERTS, D_MODEL, EXPERT_FF), D_MODEL ** -0.5),
        "w3": nrm(ks[19], (DEPTH, N_EXPERTS, D_MODEL, EXPERT_FF), D_MODEL ** -0.5),
        "w2": nrm(ks[20], (DEPTH, N_EXPERTS, EXPERT_FF, D_MODEL), DN_BETA * EXPERT_FF ** -0.5),
        "ln2_g": 1.0 + nrm(ks[21], (DEPTH, D_MODEL), 0.02),
        "ln2_b": nrm(ks[22], (DEPTH, D_MODEL), 0.02),
    }


def reference(x, c, ctx, c_ctx, w_mod, b_mod, w_in, pool_w, pool_scale, sgu_g, sgu_w, sgu_b,
              q_g, k_g, w_out, ln1_g, ln1_b, w_router, w1, w3, w2, ln2_g, ln2_b):
    B, S, _ = x.shape
    cos, sin = axial_rope(S)
    xc = ctx
    for l in range(DEPTH):
        last = l == DEPTH - 1
        sh1, sc1, g1, sh2, sc2, g2 = modulation(c, w_mod[l], b_mod[l])
        csh1, csc1, cg1, csh2, csc2, cg2 = modulation(c_ctx[None, :], w_mod[l], b_mod[l])

        hl = modulate(x, sh1, sc1)
        hc = modulate(xc, csh1, csc1)
        zl = hl @ w_in[l]
        zc_kv = hc @ w_in[l][:, OFF_K:]
        kc = rms_norm(zc_kv[..., :KV_WIDTH].reshape(B, -1, N_KV_HEADS, HEAD_DIM), k_g[l])
        vc = zc_kv[..., KV_WIDTH:].reshape(B, -1, N_KV_HEADS, HEAD_DIM)

        ql = apply_rope(rms_norm(heads(zl, OFF_Q, N_HEADS), q_g[l]), cos, sin)
        kl = apply_rope(rms_norm(heads(zl, OFF_K, N_KV_HEADS), k_g[l]), cos, sin)
        vl = heads(zl, OFF_VAL, N_KV_HEADS)
        attn_l = block_attention(ql, jnp.concatenate([kl, kc], axis=1), jnp.concatenate([vl, vc], axis=1))
        yl = mixer_output(zl, attn_l, pool_w[l], pool_scale[l], sgu_g[l], sgu_w[l], sgu_b[l], w_out[l])

        if not last:
            zc = hc @ w_in[l][:, :OFF_K]
            qc = rms_norm(heads(zc, OFF_Q, N_HEADS), q_g[l])
            attn_c = block_attention(qc, kc, vc)
            yc = mixer_output(zc, attn_c, pool_w[l], pool_scale[l], sgu_g[l], sgu_w[l], sgu_b[l], w_out[l])
            xc = layer_norm(DN_ALPHA * xc + cg1 * yc, ln1_g[l], ln1_b[l])
            mc = expert_choice_moe(modulate(xc, csh2, csc2), w_router[l], w1[l], w3[l], w2[l])
            xc = layer_norm(DN_ALPHA * xc + cg2 * mc, ln2_g[l], ln2_b[l])

        x = layer_norm(DN_ALPHA * x + g1 * yl, ln1_g[l], ln1_b[l])
        ml = expert_choice_moe(modulate(x, sh2, sc2), w_router[l], w1[l], w3[l], w2[l])
        x = layer_norm(DN_ALPHA * x + g2 * ml, ln2_g[l], ln2_b[l])
    return x
```

```cpp
#include <hip/hip_runtime.h>
#include <cstdio>
#include <cstdint>

#ifndef MK_PER_PHASE
#define MK_PER_PHASE 0
#endif

namespace pg8 {
#define PG8_LAS __attribute__((address_space(3)))
typedef unsigned short bf16_t;
typedef short bf16x8 __attribute__((ext_vector_type(8)));
typedef float f32x4 __attribute__((ext_vector_type(4)));
typedef unsigned u32x4 __attribute__((ext_vector_type(4)));
constexpr int BM = 256, BK = 64, HALF = 128, HTB = HALF * BK * 2  , STAGE_BYTES = 8 * HTB, NXCD = 8, WGM = 8;

__host__ __device__ __forceinline__ int lds_byte(int r, int c) { const int st = (r >> 4) * 2 + (c >> 5), rr = r & 15, cc = c & 31, ob = rr * 64 + cc * 2; return st * 1024 + (ob ^ (((ob >> 9) & 1) << 5)); }
__host__ __device__ __forceinline__ void stage_rc(int b, int& R, int& C) { const int st = b / 1024, sb = b % 1024, swz = sb ^ (((sb >> 9) & 1) << 5); R = (st >> 1) * 16 + swz / 64; C = (st & 1) * 32 + (swz % 64) / 2; }
__host__ __device__ __forceinline__ int perm32(int rho) { const int n = rho >> 4, i = rho & 15; return 8 * (i >> 2) + 4 * n + (i & 3); }

struct Unit { int pm, pn, e; };

__device__ __forceinline__ void xcd_remap(int& wgid, int nwg) { const int q = nwg / NXCD, r = nwg % NXCD, xcd = wgid % NXCD, off = wgid / NXCD; wgid = (xcd < r ? xcd * (q + 1) : r * (q + 1) + (xcd - r) * q) + off; }

struct DenseOrder {
    static constexpr bool GATHER = false;
    const bf16_t* A; const bf16_t* Bt; int K, nM, nN, nwg, G, c, extra_pm0, n_extra, extra_pn;
    __device__ __forceinline__ bool next(int i, Unit& u) const {
        const int L = i * G + c; u.e = 0;
        if (L >= nwg) { const int x = L - nwg; if (x >= n_extra) return false; u.pm = extra_pm0 + x; u.pn = extra_pn; return true; }
        int wgid = L; xcd_remap(wgid, nwg);
        const int nig = WGM * nN, gid = wgid / nig, fm = gid * WGM, gsz = (nM - fm) < WGM ? (nM - fm) : WGM;
        u.pm = fm + ((wgid % nig) % gsz); u.pn = (wgid % nig) / gsz; return true;
    }
    __device__ __forceinline__ const char* a_base(const Unit& u) const { return (const char*)(A + (size_t)u.pm * BM * K); }
    __device__ __forceinline__ const char* b_base(const Unit& u) const { return (const char*)(Bt + (size_t)u.pn * BM * K); }
    __device__ __forceinline__ const int* a_rows(const Unit&) const { return nullptr; }
};
template <bool GATHER_> struct MoeOrder {
    static constexpr bool GATHER = GATHER_;
    const bf16_t* A; const bf16_t* Bt; const int* rowidx; int K, nRT, nPN, ERP  , BRP  , nwg, G, c;
    __device__ __forceinline__ bool next(int i, Unit& u) const {
        const int L = i * G + c; if (L >= nwg) return false;
        int wgid = L; xcd_remap(wgid, nwg);
        const int per = nRT * nPN; u.e = wgid / per; const int rem = wgid % per; u.pm = rem / nPN; u.pn = rem % nPN; return true;
    }
    __device__ __forceinline__ const char* a_base(const Unit& u) const { return GATHER ? (const char*)A : (const char*)(A + ((size_t)u.e * ERP + (size_t)u.pm * BM) * K); }
    __device__ __forceinline__ const char* b_base(const Unit& u) const { return (const char*)(Bt + ((size_t)u.e * BRP + (size_t)u.pn * BM) * K); }
    __device__ __forceinline__ const int* a_rows(const Unit& u) const { return rowidx + (size_t)u.e * ERP + (size_t)u.pm * BM; }
};

__device__ __forceinline__ unsigned cvt_pk_bf16(float lo, float hi) { unsigned r; asm volatile("v_cvt_pk_bf16_f32 %0, %1, %2" : "=v"(r) : "v"(lo), "v"(hi)); return r; }

struct EpiBf16Plain {
    static constexpr bool PERM = true;
    bf16_t* O; int ldc;
    __device__ __forceinline__ void operator()(const f32x4 (&acc)[2][2][4][2], const Unit& u, int wr, int wc, int fr, int fq) const {
        const int row0 = u.pm * BM + wr * 64 + fr, col0 = u.pn * BM + wc * 32 + 8 * fq;
#pragma unroll
        for (int ai = 0; ai < 2; ++ai)
#pragma unroll
            for (int m = 0; m < 4; ++m) { bf16_t* rowp = O + (size_t)(row0 + ai * HALF + m * 16) * ldc + col0;
#pragma unroll
                for (int bj = 0; bj < 2; ++bj) { const f32x4 v0 = acc[ai][bj][m][0], v1 = acc[ai][bj][m][1];
                    u32x4 w; w.x = cvt_pk_bf16(v0[0], v0[1]); w.y = cvt_pk_bf16(v0[2], v0[3]); w.z = cvt_pk_bf16(v1[0], v1[1]); w.w = cvt_pk_bf16(v1[2], v1[3]);
                    *(u32x4*)(rowp + bj * HALF) = w; } }
    }
};
__device__ __forceinline__ float silu_f(float a) { return a * __builtin_amdgcn_rcpf(1.0f + __builtin_amdgcn_exp2f(-1.4426950408889634f * a)); }
struct EpiSwiglu {
    static constexpr bool PERM = true;
    bf16_t* O; int ERP;
    __device__ __forceinline__ void operator()(const f32x4 (&acc)[2][2][4][2], const Unit& u, int wr, int wc, int fr, int fq) const {
        const size_t row0 = (size_t)u.e * ERP + (size_t)u.pm * BM + wr * 64 + fr; const int col0 = u.pn * HALF + wc * 32 + 8 * fq;
#pragma unroll
        for (int ai = 0; ai < 2; ++ai)
#pragma unroll
            for (int m = 0; m < 4; ++m) { bf16_t* rowp = O + (row0 + ai * HALF + m * 16) * 1024 + col0;
                const f32x4 a0 = acc[ai][0][m][0], a1 = acc[ai][0][m][1], b0 = acc[ai][1][m][0], b1 = acc[ai][1][m][1];
                u32x4 w; w.x = cvt_pk_bf16(silu_f(a0[0]) * b0[0], silu_f(a0[1]) * b0[1]); w.y = cvt_pk_bf16(silu_f(a0[2]) * b0[2], silu_f(a0[3]) * b0[3]);
                w.z = cvt_pk_bf16(silu_f(a1[0]) * b1[0], silu_f(a1[1]) * b1[1]); w.w = cvt_pk_bf16(silu_f(a1[2]) * b1[2], silu_f(a1[3]) * b1[3]);
                *(u32x4*)rowp = w; }
    }
};
struct EpiGate {
    static constexpr bool PERM = true;
    bf16_t* O; const float* gate; int ERP;
    __device__ __forceinline__ void operator()(const f32x4 (&acc)[2][2][4][2], const Unit& u, int wr, int wc, int fr, int fq) const {
        const size_t row0 = (size_t)u.e * ERP + (size_t)u.pm * BM + wr * 64 + fr; const int col0 = u.pn * BM + wc * 32 + 8 * fq;
#pragma unroll
        for (int ai = 0; ai < 2; ++ai)
#pragma unroll
            for (int m = 0; m < 4; ++m) { const size_t row = row0 + ai * HALF + m * 16; bf16_t* rowp = O + row * 1024 + col0; const float gt = gate[row];
#pragma unroll
                for (int bj = 0; bj < 2; ++bj) { const f32x4 v0 = acc[ai][bj][m][0] * gt, v1 = acc[ai][bj][m][1] * gt;
                    u32x4 w; w.x = cvt_pk_bf16(v0[0], v0[1]); w.y = cvt_pk_bf16(v0[2], v0[3]); w.z = cvt_pk_bf16(v1[0], v1[1]); w.w = cvt_pk_bf16(v1[2], v1[3]);
                    *(u32x4*)(rowp + bj * HALF) = w; } }
    }
};

template <class Epi, class Sched, bool ALIGN_EPI>
__device__ __forceinline__ void gemm_phase(PG8_LAS unsigned char* lds, const Sched& S, const Epi& E) {
    int tid_ = threadIdx.x; asm volatile("" : "+v"(tid_));
    const int tid = tid_, wid = __builtin_amdgcn_readfirstlane(tid >> 6), lane = tid & 63, wr = wid >> 2, wc = wid & 3, fr = lane & 15, fq = lane >> 4;
    const int K = S.K, nt = K / BK;
    constexpr bool GA = Sched::GATHER;
    unsigned voffB[2]; int Rst[2]; unsigned Cst[2];
    unsigned curA[2][2], nxtA[2][2];
    const size_t hstep = (size_t)HALF * K * 2;
#pragma unroll
    for (int i = 0; i < 2; ++i) { int R, C; stage_rc(tid * 16 + i * 8192, R, C); const int Rb = Epi::PERM ? ((R & ~31) + perm32(R & 31)) : R;
        Rst[i] = R; Cst[i] = (unsigned)C * 2u; voffB[i] = (unsigned)(Rb * K + C) * 2u;
#pragma unroll
        for (int h = 0; h < 2; ++h) { curA[h][i] = (unsigned)((h * HALF + R) * K + C) * 2u; nxtA[h][i] = curA[h][i]; } }
    const size_t kstep = (size_t)(BK * 2);
    const unsigned ldsw = (unsigned)wid * 1024u;
    const int aoff = lds_byte(wr * 64 + fr, fq * 8), boff = lds_byte(wc * 32 + fr, fq * 8);
#define PG8_SA(b, h) (((b) * 2 + (h)) * HTB)
#define PG8_SB(b, h) ((4 + (b) * 2 + (h)) * HTB)
#define PG8_STAGE(bufoff, gbase, voff) do { _Pragma("unroll") for (int _i = 0; _i < 2; ++_i) \
        __builtin_amdgcn_global_load_lds((const unsigned*)((const char*)(gbase) + (voff)[_i]), (PG8_LAS unsigned*)(lds + (bufoff) + ldsw + _i * 8192), 16, 0, 0); } while (0)
#define PG8_LDA(dst, b, h) do { _Pragma("unroll") for (int m = 0; m < 4; ++m) _Pragma("unroll") for (int k = 0; k < 2; ++k) dst[m][k] = *(const PG8_LAS bf16x8*)(lds + PG8_SA(b, h) + aoff + m * 2048 + k * 1024); } while (0)
#define PG8_LDB(dst, b, h) do { _Pragma("unroll") for (int n = 0; n < 2; ++n) _Pragma("unroll") for (int k = 0; k < 2; ++k) dst[n][k] = *(const PG8_LAS bf16x8*)(lds + PG8_SB(b, h) + boff + n * 2048 + k * 1024); } while (0)
#define PG8_MMA(ai, bj, At, Bt) do { __builtin_amdgcn_s_setprio(1); _Pragma("unroll") for (int m = 0; m < 4; ++m) _Pragma("unroll") for (int n = 0; n < 2; ++n) _Pragma("unroll") for (int k = 0; k < 2; ++k) \
        acc[ai][bj][m][n] = __builtin_amdgcn_mfma_f32_16x16x32_bf16(Bt[n][k], At[m][k], acc[ai][bj][m][n], 0, 0, 0); __builtin_amdgcn_s_setprio(0); } while (0)
#define PG8_WAIT_V(n) asm volatile("s_waitcnt vmcnt(" #n ")" ::: "memory")
#define PG8_WAIT_L(n) asm volatile("s_waitcnt lgkmcnt(" #n ")" ::: "memory")
#define PG8_BAR __builtin_amdgcn_s_barrier()
#define PG8_SCHED __builtin_amdgcn_sched_barrier(0)
#define PG8_ROWS(dst, u) do { if constexpr (GA) { const int* _rw = S.a_rows(u); _Pragma("unroll") for (int _h = 0; _h < 2; ++_h) _Pragma("unroll") for (int _i = 0; _i < 2; ++_i) \
        dst[_h][_i] = (unsigned)_rw[_h * HALF + Rst[_i]] * (unsigned)(K * 2) + Cst[_i]; } } while (0)
    Unit cur, nxt; int ui = 0;
    if (!S.next(0, cur)) return;
    f32x4 acc[2][2][4][2];
#pragma unroll
    for (int a = 0; a < 2; ++a)
#pragma unroll
        for (int b = 0; b < 2; ++b)
#pragma unroll
            for (int m = 0; m < 4; ++m)
#pragma unroll
                for (int n = 0; n < 2; ++n) acc[a][b][m][n] = (f32x4){0.f, 0.f, 0.f, 0.f};
    bf16x8 At[4][2], B0[2][2], B1[2][2];
    const char* cA = S.a_base(cur); const char* cB = S.b_base(cur);
    PG8_ROWS(curA, cur);
    PG8_STAGE(PG8_SB(0, 0), cB, voffB); PG8_STAGE(PG8_SB(0, 1), cB + hstep, voffB); PG8_STAGE(PG8_SA(0, 0), cA, curA[0]); PG8_STAGE(PG8_SA(0, 1), cA, curA[1]);
    if (wr == 1) PG8_BAR;
    PG8_WAIT_V(2); PG8_BAR;
    PG8_STAGE(PG8_SB(1, 0), cB + kstep, voffB); PG8_STAGE(PG8_SA(1, 0), cA + kstep, curA[0]); PG8_STAGE(PG8_SB(1, 1), cB + hstep + kstep, voffB);
    PG8_WAIT_V(6); PG8_BAR;
    for (;;) {
        const bool has_next = S.next(ui + 1, nxt);
        const char* nA = has_next ? S.a_base(nxt) : cA; const char* nB = has_next ? S.b_base(nxt) : cB;
        for (int t = 0; t < nt; t += 2) {
            const bool last = (t == nt - 2);
            const char* a1 = cA + (size_t)(t + 1) * kstep;
            const char* a2 = last ? nA : cA + (size_t)(t + 2) * kstep; const char* b2 = last ? nB : cB + (size_t)(t + 2) * kstep;
            const char* a3 = a2 + kstep; const char* b3 = b2 + kstep;
            unsigned o2[2][2];
            if constexpr (GA) { if (last && has_next) { PG8_ROWS(nxtA, nxt); } else if (last) { _Pragma("unroll") for (int h = 0; h < 2; ++h) _Pragma("unroll") for (int i = 0; i < 2; ++i) nxtA[h][i] = curA[h][i]; } }
#pragma unroll
            for (int h = 0; h < 2; ++h)
#pragma unroll
                for (int i = 0; i < 2; ++i) o2[h][i] = (GA && last) ? nxtA[h][i] : curA[h][i];
            PG8_LDB(B0, 0, 0); PG8_LDB(B1, 0, 1); PG8_SCHED; PG8_LDA(At, 0, 0); PG8_STAGE(PG8_SA(1, 1), a1, curA[1]);
            PG8_WAIT_V(8); PG8_WAIT_L(0); PG8_BAR; PG8_MMA(0, 0, At, B0); PG8_MMA(0, 1, At, B1); PG8_BAR; PG8_SCHED;
            PG8_LDA(At, 0, 1); PG8_STAGE(PG8_SB(0, 0), b2, voffB); PG8_STAGE(PG8_SB(0, 1), b2 + hstep, voffB); PG8_STAGE(PG8_SA(0, 0), a2, o2[0]);
            PG8_WAIT_V(8); PG8_WAIT_L(0); PG8_BAR; PG8_MMA(1, 0, At, B0); PG8_MMA(1, 1, At, B1); PG8_BAR; PG8_SCHED;
            PG8_LDB(B0, 1, 0); PG8_LDB(B1, 1, 1); PG8_SCHED; PG8_LDA(At, 1, 0); PG8_STAGE(PG8_SA(0, 1), a2, o2[1]);
            PG8_WAIT_V(8); PG8_WAIT_L(0); PG8_BAR; PG8_MMA(0, 0, At, B0); PG8_MMA(0, 1, At, B1); PG8_BAR; PG8_SCHED;
            PG8_LDA(At, 1, 1); PG8_STAGE(PG8_SB(1, 0), b3, voffB); PG8_STAGE(PG8_SB(1, 1), b3 + hstep, voffB); PG8_STAGE(PG8_SA(1, 0), a3, o2[0]);
            PG8_WAIT_V(8); PG8_WAIT_L(0); PG8_BAR; PG8_MMA(1, 0, At, B0); PG8_MMA(1, 1, At, B1); PG8_BAR; PG8_SCHED;
        }
        if constexpr (ALIGN_EPI) { if (wr == 0) PG8_BAR; }
        E(acc, cur, wr, wc, fr, fq);
        if (!has_next) break;
#pragma unroll
        for (int a = 0; a < 2; ++a)
#pragma unroll
            for (int b = 0; b < 2; ++b)
#pragma unroll
                for (int m = 0; m < 4; ++m)
#pragma unroll
                    for (int n = 0; n < 2; ++n) acc[a][b][m][n] = (f32x4){0.f, 0.f, 0.f, 0.f};
        cur = nxt; cA = nA; cB = nB; ++ui;
        if constexpr (GA) {
#pragma unroll
            for (int h = 0; h < 2; ++h)
#pragma unroll
                for (int i = 0; i < 2; ++i) curA[h][i] = nxtA[h][i]; }
        if constexpr (ALIGN_EPI) { if (wr == 1) PG8_BAR; }
    }
    PG8_WAIT_V(0);
    if constexpr (!ALIGN_EPI) { if (wr == 0) PG8_BAR; }
    PG8_BAR;
#undef PG8_SA
#undef PG8_SB
#undef PG8_STAGE
#undef PG8_LDA
#undef PG8_LDB
#undef PG8_MMA
#undef PG8_WAIT_V
#undef PG8_WAIT_L
#undef PG8_BAR
#undef PG8_SCHED
#undef PG8_ROWS
}
}
#include <hip/hip_bf16.h>
#include <cmath>
namespace attn_body {
using bf16=__hip_bfloat16;
using bf16x8=__attribute__((ext_vector_type(8)))short;
using s16x4=__attribute__((ext_vector_type(4)))short;
using f32x16=__attribute__((ext_vector_type(16)))float;
using u32x4=__attribute__((ext_vector_type(4)))unsigned;
constexpr int D=64,QP=512,KP=128,OP=1024;
constexpr int NW=8,QBLK=32,QB=QBLK*NW,KVBLK=64;
constexpr int ATTN_UNIT_ROWS=QB;
__device__ __forceinline__ int crow(int r,int hi){return (r&3)+8*(r>>2)+4*hi;}
#define SBAR() __builtin_amdgcn_sched_barrier(0)

constexpr int NSLOT=3, SLOTB=8192;
constexpr int LDS_K=0, LDS_V=NSLOT*SLOTB, LDS_WS=2*NSLOT*SLOTB, LDS_OST=LDS_WS+NW*64*4, LDS_BYTES=LDS_OST+NW*4096;
constexpr float C2=0.125f*1.4426950408889634f;
__device__ __forceinline__ void glds16(const void*gsrc,unsigned lds_dst){unsigned keep;
  asm volatile("s_mov_b32 %0, m0\n\ts_mov_b32 m0, %2\n\ts_nop 0\n\tglobal_load_lds_dwordx4 %1, off\n\ts_mov_b32 m0, %0":"=&s"(keep):"v"(gsrc),"s"(lds_dst):"memory");}
__device__ __forceinline__ float max3f(float a,float b,float c){float r;asm("v_max3_f32 %0, %1, %2, %3":"=v"(r):"v"(a),"v"(b),"v"(c));return r;}
__device__ __forceinline__ float max2f(float a,float b){float r;asm("v_max_f32_e32 %0, %1, %2":"=v"(r):"v"(a),"v"(b));return r;}
__device__ __forceinline__ float fadd_s(float a,float b){float r;asm("v_add_f32_e32 %0, %1, %2":"=v"(r):"v"(a),"v"(b));return r;}
__device__ __forceinline__ float fsub_s(float a,float b){float r;asm("v_sub_f32_e32 %0, %1, %2":"=v"(r):"v"(a),"v"(b));return r;}
typedef float f32x2_t __attribute__((ext_vector_type(2))); typedef __bf16 bf16x2_t __attribute__((ext_vector_type(2)));
__device__ __forceinline__ unsigned cvtpk_s(float lo,float hi){f32x2_t v={lo,hi};bf16x2_t b=__builtin_convertvector(v,bf16x2_t);return __builtin_bit_cast(unsigned,b);}
#define WAIT_BAR(N) asm volatile("s_waitcnt vmcnt(" #N ") lgkmcnt(0)\n\ts_barrier":::"memory")

__device__ __forceinline__ void qkt(f32x16&p0,f32x16&p1,const char*Kslot,const bf16x8*qr,const f32x16&negm,int r32,int hi){
  const char*kb=Kslot+hi*1024+r32*16;
  #pragma unroll
  for(int d0=0;d0<4;++d0){
    const bf16x8 b0=*reinterpret_cast<const bf16x8*>(kb+d0*2048);
    const bf16x8 b1=*reinterpret_cast<const bf16x8*>(kb+d0*2048+512);
    if(d0==0){p0=__builtin_amdgcn_mfma_f32_32x32x16_bf16(b0,qr[0],negm,0,0,0);p1=__builtin_amdgcn_mfma_f32_32x32x16_bf16(b1,qr[0],negm,0,0,0);}
    else{p0=__builtin_amdgcn_mfma_f32_32x32x16_bf16(b0,qr[d0],p0,0,0,0);p1=__builtin_amdgcn_mfma_f32_32x32x16_bf16(b1,qr[d0],p1,0,0,0);}}
}
typedef __attribute__((address_space(3))) const char* lds_cptr;
typedef short v4i16_t __attribute__((ext_vector_type(4)));
__device__ __forceinline__ void kload8(bf16x8*kf,lds_cptr kp){
  kf[0]=*(const __attribute__((address_space(3))) bf16x8*)(kp);      kf[1]=*(const __attribute__((address_space(3))) bf16x8*)(kp+512);
  kf[2]=*(const __attribute__((address_space(3))) bf16x8*)(kp+2048); kf[3]=*(const __attribute__((address_space(3))) bf16x8*)(kp+2560);
  kf[4]=*(const __attribute__((address_space(3))) bf16x8*)(kp+4096); kf[5]=*(const __attribute__((address_space(3))) bf16x8*)(kp+4608);
  kf[6]=*(const __attribute__((address_space(3))) bf16x8*)(kp+6144); kf[7]=*(const __attribute__((address_space(3))) bf16x8*)(kp+6656);
}
__device__ __forceinline__ void kload2(bf16x8*kf,lds_cptr kp,int j){ kf[2*j]=*(const __attribute__((address_space(3))) bf16x8*)(kp+j*2048); kf[2*j+1]=*(const __attribute__((address_space(3))) bf16x8*)(kp+j*2048+512); }
__device__ __forceinline__ s16x4 vtr(lds_cptr p){ return __builtin_bit_cast(s16x4,__builtin_amdgcn_ds_read_tr16_b64_v4i16((__attribute__((address_space(3))) v4i16_t*)p)); }
__device__ __forceinline__ float rowmax(const f32x16&p0,const f32x16&p1){
  float a=max3f(p0[0],p0[1],p1[0]),b=max3f(p0[2],p0[3],p1[1]);a=max3f(a,p1[2],p1[3]);
  #pragma unroll
  for(int r=4;r<16;r+=4){a=max3f(a,p0[r],p0[r+1]);b=max3f(b,p0[r+2],p0[r+3]);a=max3f(a,p1[r],p1[r+1]);b=max3f(b,p1[r+2],p1[r+3]);}
  const float m=max2f(a,b);
  auto rr=__builtin_amdgcn_permlane32_swap(__float_as_uint(m),__float_as_uint(m),false,false);
  return max2f(__uint_as_float(rr[0]),__uint_as_float(rr[1]));
}
__device__ __forceinline__ void pv(f32x16*o,int vb,bf16x8 pa0,bf16x8 pa1,bf16x8 pa2,bf16x8 pa3){
  #pragma unroll
  for(int d0=0;d0<2;++d0){s16x4 lo[4],hi[4];
    #pragma unroll
    for(int ks=0;ks<4;++ks){
      asm volatile("ds_read_b64_tr_b16 %0,%1 offset:%c2":"=&v"(lo[ks]):"v"(vb),"i"(d0*4096+ks*1024):"memory");
      asm volatile("ds_read_b64_tr_b16 %0,%1 offset:%c2":"=&v"(hi[ks]):"v"(vb),"i"(d0*4096+ks*1024+512):"memory");}
    asm volatile("s_waitcnt lgkmcnt(0)":::"memory");SBAR();
    #define PK(k) (bf16x8){lo[k][0],lo[k][1],lo[k][2],lo[k][3],hi[k][0],hi[k][1],hi[k][2],hi[k][3]}
    o[d0]=__builtin_amdgcn_mfma_f32_32x32x16_bf16(pa0,PK(0),o[d0],0,0,0);
    o[d0]=__builtin_amdgcn_mfma_f32_32x32x16_bf16(pa1,PK(1),o[d0],0,0,0);
    o[d0]=__builtin_amdgcn_mfma_f32_32x32x16_bf16(pa2,PK(2),o[d0],0,0,0);
    o[d0]=__builtin_amdgcn_mfma_f32_32x32x16_bf16(pa3,PK(3),o[d0],0,0,0);
    #undef PK
  }
}

#ifndef ATTN_STORE16
#define ATTN_STORE16(p,v) (*(u32x4*)(p)=(v))
#endif
template<int THRL> __device__ __forceinline__ void attn_unit(const bf16*Qu,const bf16*__restrict__ Kh,const bf16*__restrict__ Vh,bf16*Ou,const int NT,char*shm){
  int tid_=threadIdx.x; asm volatile("":"+v"(tid_)); const int tid=tid_,lane=tid&63,r32=lane&31,hi=lane>>5; const int wid=__builtin_amdgcn_readfirstlane(tid>>6);
  const bf16*Qw=Qu+(long)(wid*QBLK)*QP;
  const unsigned lds0=(unsigned)(uintptr_t)shm;
  float*wsf=(float*)(shm+LDS_WS)+wid*64;
  const bf16*ksrc=Kh+(long)lane*KP+wid*8;
  const bf16*vsrc=Vh+(long)(16*(wid&3)+(lane>>2))*KP+(wid>>2)*32+(lane&3)*8;
  const unsigned kdst=lds0+LDS_K+wid*1024, vdst=lds0+LDS_V+wid*1024;
  #define DMA_K(t,slot) glds16(ksrc+(long)(t)*KVBLK*KP,(unsigned)__builtin_amdgcn_readfirstlane(kdst+(slot)))
  #define DMA_V(t,slot) glds16(vsrc+(long)(t)*KVBLK*KP,(unsigned)__builtin_amdgcn_readfirstlane(vdst+(slot)))
  const int vb0=(int)(lds0+LDS_V)+((lane>>4)&1)*32+(lane&3)*8+(4*hi+((lane&15)>>2))*64;
  const char*Kbase=shm+LDS_K; bf16x8 kf[8];
  const lds_cptr shm3=(lds_cptr)shm; const lds_cptr kp0=shm3+LDS_K+hi*1024+r32*16; const lds_cptr vp0=shm3+LDS_V+((lane>>4)&1)*32+(lane&3)*8+(4*hi+((lane&15)>>2))*64;
  DMA_K(0,0);DMA_V(0,0);DMA_K(1,SLOTB);
  bf16x8 qr[4];
  #pragma unroll
  for(int d0=0;d0<4;++d0)qr[d0]=*reinterpret_cast<const bf16x8*>(&Qw[(long)r32*QP+d0*16+hi*8]);
  float mhat=0.f,l_reg=0.f;f32x16 o[2];o[0]=f32x16{};o[1]=f32x16{};f32x16 negm=f32x16{};asm volatile("":"+v"(negm));
  #define CMASK(P0,P1,t) do{}while(0)
  bool resc=false;
  #define START(P0,P1) do{ const float rm=rowmax(P0,P1); resc=false; \
    { const float dl=rm; mhat=fadd_s(mhat,dl); \
      _Pragma("unroll") for(int r=0;r<16;++r){P0[r]=fsub_s(P0[r],dl);P1[r]=fsub_s(P1[r],dl);} \
      _Pragma("unroll") for(int r=0;r<16;++r)negm[r]=-mhat; asm volatile("":"+v"(negm)); } \
    _Pragma("unroll") for(int r=0;r<16;++r)P0[r]=__builtin_amdgcn_exp2f(P0[r]); }while(0)
  #define RESC() do{ if(resc){ asm volatile("s_waitcnt lgkmcnt(0)":::"memory"); \
      _Pragma("unroll") for(int d_=0;d_<2;++d_) _Pragma("unroll") for(int r=0;r<16;++r)o[d_][r]*=wsf[crow(r,hi)]; } }while(0)
  f32x16 pA0,pA1,pB0,pB1;
  int sl_prev=0,sl_cur=0,sl_next=SLOTB;
  #define ROT() do{sl_prev=sl_cur;sl_cur=sl_next;sl_next=(sl_next==(NSLOT-1)*SLOTB)?0:sl_next+SLOTB;}while(0)
  DMA_K(2,2*SLOTB);
  WAIT_BAR(3);
  qkt(pA0,pA1,Kbase,qr,negm,r32,hi);asm volatile("s_nop 15\n\ts_nop 7":"+v"(pA0),"+v"(pA1));CMASK(pA0,pA1,0);
  START(pA0,pA1);
  _Pragma("unroll") for(int r=0;r<16;++r)pA1[r]=__builtin_amdgcn_exp2f(pA1[r]);
  WAIT_BAR(0);
  DMA_K(3,0);DMA_V(1,SLOTB);
  ROT();
  kload8(kf,kp0+sl_cur);
  WAIT_BAR(2);
  s16x4 vlo[8],vhi[8]; u32x4 pw0,pw1,pw2,pw3;
  #define PKW(P,B) cvtpk_s(P[B],P[B+1])
  #define PAF(k) __builtin_bit_cast(bf16x8,pw##k)
  #define VFR(i) (bf16x8){vlo[i][0],vlo[i][1],vlo[i][2],vlo[i][3],vhi[i][0],vhi[i][1],vhi[i][2],vhi[i][3]}
  #define PIN(x) asm volatile("":"+v"(x))
  #define MX3(a,b,c) __builtin_fmaxf(__builtin_fmaxf((a),(b)),(c))
  #define GAPA(MF,A0,A1,A2,A3,W0,W1,PW) do{ MF; sacc+=A0; sacc+=A1; sacc+=A2; sacc+=A3; PIN(sacc); W0; W1; PIN(PW); SBAR(); }while(0)
  #define EX(v) __builtin_amdgcn_exp2f(v)
  #define GAPB(MF,X,B) do{ MF; X[B]=EX(X[B]); X[B+1]=EX(X[B+1]); X[B+2]=EX(X[B+2]); X[B+3]=EX(X[B+3]); PIN(X); SBAR(); }while(0)
  #define VRD(i) do{ vlo[i]=vtr(vp_+(((i)>>2)*4096+((i)&3)*1024)); vhi[i]=vtr(vp_+(((i)>>2)*4096+((i)&3)*1024+512)); }while(0)
  #define KRD(G,j) do{ if(G){ kload2(kf,kp0+sl_next,j); SBAR(); } }while(0)
  #define STEP(C0,C1,P0,P1,t,GK,GV,GL) do{ SBAR(); \
    const lds_cptr vp_=vp0+sl_prev; \
    VRD(0); SBAR(); float sacc=(P0[0]+P0[1]); \
    GAPA(C0=__builtin_amdgcn_mfma_f32_32x32x16_bf16(kf[0],qr[0],negm,0,0,0), P0[2],P0[3],P0[4],P0[5],     pw0[0]=PKW(P0,0), pw0[1]=PKW(P0,2), pw0); \
    VRD(4); SBAR(); GAPA(C1=__builtin_amdgcn_mfma_f32_32x32x16_bf16(kf[1],qr[0],negm,0,0,0), P0[6],P0[7],P0[8],P0[9],     pw0[2]=PKW(P0,4), pw0[3]=PKW(P0,6), pw0); \
    VRD(1); SBAR(); GAPA(C0=__builtin_amdgcn_mfma_f32_32x32x16_bf16(kf[2],qr[1],C0,0,0,0),   P0[10],P0[11],P0[12],P0[13], pw1[0]=PKW(P0,8), pw1[1]=PKW(P0,10), pw1); \
    VRD(5); SBAR(); GAPA(C1=__builtin_amdgcn_mfma_f32_32x32x16_bf16(kf[3],qr[1],C1,0,0,0),   P0[14],P0[15],P1[0],P1[1],   pw1[2]=PKW(P0,12),pw1[3]=PKW(P0,14), pw1); \
    VRD(2); SBAR(); GAPA(C0=__builtin_amdgcn_mfma_f32_32x32x16_bf16(kf[4],qr[2],C0,0,0,0),   P1[2],P1[3],P1[4],P1[5],     pw2[0]=PKW(P1,0), pw2[1]=PKW(P1,2), pw2); \
    VRD(6); SBAR(); GAPA(C1=__builtin_amdgcn_mfma_f32_32x32x16_bf16(kf[5],qr[2],C1,0,0,0),   P1[6],P1[7],P1[8],P1[9],     pw2[2]=PKW(P1,4), pw2[3]=PKW(P1,6), pw2); \
    VRD(3); SBAR(); GAPA(C0=__builtin_amdgcn_mfma_f32_32x32x16_bf16(kf[6],qr[3],C0,0,0,0),   P1[10],P1[11],P1[12],P1[13], pw3[0]=PKW(P1,8), pw3[1]=PKW(P1,10), pw3); \
    VRD(7); SBAR(); GAPA(C1=__builtin_amdgcn_mfma_f32_32x32x16_bf16(kf[7],qr[3],C1,0,0,0),   P1[14],P1[15],0.f,0.f,       pw3[2]=PKW(P1,12),pw3[3]=PKW(P1,14), pw3); \
    l_reg+=sacc; \
    if(GK){DMA_K((t)+3,sl_cur);} if(GV){DMA_V((t)+1,sl_next);} \
    CMASK(C0,C1,t); \
    { float a=MX3(C0[0],C0[1],C1[0]),b=MX3(C0[2],C0[3],C1[1]); a=MX3(a,C1[2],C1[3]); \
      _Pragma("unroll") for(int r=4;r<16;r+=4){a=MX3(a,C0[r],C0[r+1]);b=MX3(b,C0[r+2],C0[r+3]);a=MX3(a,C1[r],C1[r+1]);b=MX3(b,C1[r+2],C1[r+3]);} \
      float rm=__builtin_fmaxf(a,b); { auto rr=__builtin_amdgcn_permlane32_swap(__float_as_uint(rm),__float_as_uint(rm),false,false); rm=__builtin_fmaxf(__uint_as_float(rr[0]),__uint_as_float(rr[1])); } \
      resc=false; \
      if(__builtin_expect(__any(rm>(float)THRL),0)){ const float dl=__builtin_fmaxf(rm,0.f); mhat+=dl; \
        _Pragma("unroll") for(int r=0;r<16;++r){C0[r]-=dl;C1[r]-=dl;} \
        _Pragma("unroll") for(int r=0;r<16;++r)negm[r]=-mhat; asm volatile("":"+v"(negm)); \
        const float f=__builtin_amdgcn_exp2f(-dl); l_reg*=f; if(hi==0)wsf[r32]=f; resc=true; } } \
    SBAR(); \
    GAPB(o[0]=__builtin_amdgcn_mfma_f32_32x32x16_bf16(PAF(0),VFR(0),o[0],0,0,0), C0,0); \
    GAPB(o[1]=__builtin_amdgcn_mfma_f32_32x32x16_bf16(PAF(0),VFR(4),o[1],0,0,0), C0,4); \
    KRD(GL,0); GAPB(o[0]=__builtin_amdgcn_mfma_f32_32x32x16_bf16(PAF(1),VFR(1),o[0],0,0,0), C0,8); \
    KRD(GL,1); GAPB(o[1]=__builtin_amdgcn_mfma_f32_32x32x16_bf16(PAF(1),VFR(5),o[1],0,0,0), C0,12); \
    KRD(GL,2); GAPB(o[0]=__builtin_amdgcn_mfma_f32_32x32x16_bf16(PAF(2),VFR(2),o[0],0,0,0), C1,0); \
    KRD(GL,3); GAPB(o[1]=__builtin_amdgcn_mfma_f32_32x32x16_bf16(PAF(2),VFR(6),o[1],0,0,0), C1,4); \
    GAPB(o[0]=__builtin_amdgcn_mfma_f32_32x32x16_bf16(PAF(3),VFR(3),o[0],0,0,0), C1,8); \
    GAPB(o[1]=__builtin_amdgcn_mfma_f32_32x32x16_bf16(PAF(3),VFR(7),o[1],0,0,0), C1,12); \
    }while(0)
  int t=1;
  #undef CMASK
  #define CMASK(P0,P1,t) do{}while(0)
  for(;t+5<NT;t+=2){
    STEP(pB0,pB1,pA0,pA1,t,true,true,true);     WAIT_BAR(2); RESC(); ROT();
    STEP(pA0,pA1,pB0,pB1,t+1,true,true,true);   WAIT_BAR(2); RESC(); ROT();
  }
  #undef CMASK
  #define CMASK(P0,P1,t) do{}while(0)
  #define ENDW(tt) do{ if((tt)+3<NT){WAIT_BAR(2);} else if((tt)+2<NT){WAIT_BAR(1);} else {WAIT_BAR(0);} }while(0)
  for(;t+1<NT;t+=2){
    STEP(pB0,pB1,pA0,pA1,t,(t+3<NT),(t+1<NT),(t+1<NT));       ENDW(t);   RESC(); ROT();
    STEP(pA0,pA1,pB0,pB1,t+1,(t+4<NT),(t+2<NT),(t+2<NT));     ENDW(t+1); RESC(); ROT();
  }
  STEP(pB0,pB1,pA0,pA1,NT-1,false,false,false); RESC();
  { float sacc=pB0[0]+pB0[1]; _Pragma("unroll") for(int r=2;r<16;++r)sacc+=pB0[r]; _Pragma("unroll") for(int r=0;r<16;++r)sacc+=pB1[r]; l_reg+=sacc;
    pw0=(u32x4){PKW(pB0,0),PKW(pB0,2),PKW(pB0,4),PKW(pB0,6)};pw1=(u32x4){PKW(pB0,8),PKW(pB0,10),PKW(pB0,12),PKW(pB0,14)};pw2=(u32x4){PKW(pB1,0),PKW(pB1,2),PKW(pB1,4),PKW(pB1,6)};pw3=(u32x4){PKW(pB1,8),PKW(pB1,10),PKW(pB1,12),PKW(pB1,14)};
    SBAR(); pv(o,vb0+sl_cur,PAF(0),PAF(1),PAF(2),PAF(3)); }
  #undef PKW
  #undef PAF
  #undef VFR
  #undef PIN
  #undef MX3
  #undef GAPA
  #undef GAPB
  #undef EX
  #undef VRD
  #undef KRD
  #undef STEP
  #undef ENDW
  {auto rr=__builtin_amdgcn_permlane32_swap(__float_as_uint(l_reg),__float_as_uint(l_reg),false,false);l_reg=__uint_as_float(rr[0])+__uint_as_float(rr[1]);}
  if(hi==0)wsf[32+r32]=l_reg;asm volatile("s_waitcnt lgkmcnt(0)":::"memory");
  float rli[16];
  #pragma unroll
  for(int r=0;r<16;++r)rli[r]=__builtin_amdgcn_rcpf(wsf[32+crow(r,hi)]);
  bf16*Ow=Ou+(long)(wid*QBLK)*OP;
  { bf16*stg=(bf16*)(shm+LDS_OST)+wid*2048;
    #pragma unroll
    for(int r=0;r<16;++r){const int orow=crow(r,hi);
      #pragma unroll
      for(int d0=0;d0<2;++d0)stg[orow*64+d0*32+r32]=__float2bfloat16(o[d0][r]*rli[r]);}
    asm volatile("s_waitcnt lgkmcnt(0)":::"memory");
    #pragma unroll
    for(int i=0;i<4;++i){const int row=i*8+(lane>>3),ch=lane&7; const u32x4 v=*(const u32x4*)(stg+row*64+ch*8); ATTN_STORE16(Ow+(long)row*OP+ch*8,v);} }
  asm volatile("s_waitcnt lgkmcnt(0)\n\ts_barrier":::"memory");
  #undef DMA_K
  #undef DMA_V
  #undef CMASK
  #undef START
  #undef RESC
  #undef ROT
}
constexpr int ATTN_LDS_BYTES=LDS_BYTES;
#undef SBAR
#undef WAIT_BAR
}


constexpr int NWAVES = 8;
constexpr int D = 1024, NBATCH = 8, SEQ = 4096, DEPTH = 4, CTXL = 256;
constexpr int TLAT = NBATCH * SEQ, TCTX = NBATCH * CTXL, TTOK = TLAT + TCTX;
constexpr int INW = 1536, OFF_POOL = 0, OFF_U = 256, OFF_V = 512, OFF_Q = 768, OFF_K = 1280, OFF_VAL = 1408;
constexpr int NEXP = 16, CAP_L = 512, CAP_C = 32, EROWS = NBATCH * CAP_L + NBATCH * CAP_C;
constexpr int KVROWS = SEQ + CTXL;
constexpr float LN_EPS = 1e-6f;
constexpr float DN_ALPHA = 1.681792830507429f;
constexpr int MODW = 6 * D;
constexpr int NCOND = 9;

constexpr size_t MiB = 1u << 20;
constexpr size_t WS_CTL = 0, CTL_ZERO_BYTES = 1 * MiB;
constexpr size_t WS_MOD = 1 * MiB;
constexpr size_t WS_AFF = 2 * MiB;
constexpr size_t WS_INV = 5 * MiB;
constexpr size_t WS_ROWIDX = 8 * MiB;
constexpr size_t WS_GATE = 8 * MiB + 512 * 1024;
constexpr size_t WS_COS = 9 * MiB, WS_SIN = 9 * MiB + 512 * 1024;
constexpr size_t WS_SGUW = 10 * MiB;
constexpr size_t WS_PWT = 10 * MiB + 512 * 1024;
constexpr size_t WS_WIN = 12 * MiB;
constexpr size_t WS_WOUT = 24 * MiB;
constexpr size_t WS_W13 = 32 * MiB;
constexpr size_t WS_W2 = 288 * MiB;
constexpr size_t WS_X = 416 * MiB;
constexpr size_t WS_H = 552 * MiB;
constexpr size_t WS_Z = 620 * MiB;
constexpr size_t WS_Q = 722 * MiB;
constexpr size_t WS_HID = 620 * MiB;
constexpr size_t WS_MIX = 756 * MiB;
constexpr size_t WS_Y = 824 * MiB;
constexpr size_t WS_YEXP = 756 * MiB;
constexpr size_t WS_K = 892 * MiB, WS_V = 901 * MiB;
constexpr size_t WS_END = 910 * MiB;
constexpr int CW_BAR = 4096;

constexpr int RING_OFF = 0, RING_BYTES = 131072;
constexpr int LDSCTL_OFF = RING_BYTES, MISC_OFF = LDSCTL_OFF + 320;
constexpr int LDS_BYTES = 147456;

#define GAS __attribute__((address_space(1)))
#define LAS __attribute__((address_space(3)))
typedef unsigned short bf16;
typedef unsigned v4u __attribute__((ext_vector_type(4)));
typedef unsigned v2u __attribute__((ext_vector_type(2)));
typedef float f32x4 __attribute__((ext_vector_type(4)));
typedef float f32x2 __attribute__((ext_vector_type(2)));
typedef short bf16x8 __attribute__((ext_vector_type(8)));
#define LDS_WAIT() asm volatile("s_waitcnt lgkmcnt(0)" ::: "memory")
__device__ __forceinline__ unsigned f2bf(float f) { unsigned u = __builtin_bit_cast(unsigned, f); return (u + 0x7fffu + ((u >> 16) & 1u)) >> 16; }
__device__ __forceinline__ unsigned pk2(float lo, float hi) { return f2bf(lo) | (f2bf(hi) << 16); }
__device__ __forceinline__ float bflo(unsigned w) { return __builtin_bit_cast(float, w << 16); }
__device__ __forceinline__ float bfhi(unsigned w) { return __builtin_bit_cast(float, w & 0xffff0000u); }
__device__ __forceinline__ float bf1(bf16 b) { return __builtin_bit_cast(float, ((unsigned)b) << 16); }
__device__ __forceinline__ float gelu_tanh(float x) {
    const float u = 0.7978845608028654f * (x + 0.044715f * x * x * x);
    return x * __builtin_amdgcn_rcpf(1.0f + __builtin_amdgcn_exp2f(-2.8853900817779268f * u));
}

#define XB_TMO      128
#define XB_XCNT(j)  (256  + 64 * (j))
#define XB_XSUB(j)  (1280 + 64 * (j))
#define XB_XGEN(j)  (2304 + 64 * (j))
#define XB_TOP      3328
#define XB_TOPGEN   3392
#define XCD_BAR_WORDS 3456
#define XB_SPIN_CAP (1u << 18)

__device__ __forceinline__ unsigned xb_ld(unsigned* p)              { return __hip_atomic_load(p, __ATOMIC_RELAXED, __HIP_MEMORY_SCOPE_AGENT); }
__device__ __forceinline__ unsigned xb_add(unsigned* p, unsigned v) { return __hip_atomic_fetch_add(p, v, __ATOMIC_RELAXED, __HIP_MEMORY_SCOPE_AGENT); }
__device__ __forceinline__ unsigned xb_xcc_id() { return (unsigned)__builtin_amdgcn_s_getreg((3 << 11) | 20) & 0xFu; }
#define XB_SPIN(cond, bar) do { unsigned _sp = 0; while (cond) { __builtin_amdgcn_s_sleep(1); \
    if ((++_sp & 255u) == 0u) { if (xb_ld(&(bar)[XB_TMO])) break; if (_sp > XB_SPIN_CAP) { atomicAdd(&(bar)[XB_TMO], 1u); break; } } } } while (0)

struct XcdBarrier {
    unsigned* bar; unsigned x;
    volatile LAS unsigned* st;
};
__device__ __forceinline__ XcdBarrier xcd_barrier_post(unsigned* bar, volatile LAS unsigned* st) {
    XcdBarrier b; b.bar = bar; b.x = xb_xcc_id(); b.st = st;
    if (threadIdx.x == 0) (void)xb_add(&bar[XB_XCNT(b.x)], 1u);
    return b;
}
__device__ __forceinline__ void xcd_barrier_complete(unsigned* bar, unsigned x, unsigned& nloc, unsigned& nx) {
    const unsigned G = gridDim.x * gridDim.y * gridDim.z;
    unsigned sum, cnt, mine, sp = 0u;
    for (;;) {
        sum = 0u; cnt = 0u; mine = 0u;
#pragma unroll
        for (unsigned j = 0; j < 16; ++j) { const unsigned c = xb_ld(&bar[XB_XCNT(j)]); sum += c; cnt += (c > 0u) ? 1u : 0u; mine = (j == x) ? c : mine; }
        if (sum == G) break;
        __builtin_amdgcn_s_sleep(1);
        if ((++sp & 255u) == 0u) { if (xb_ld(&bar[XB_TMO])) break; if (sp > XB_SPIN_CAP) { atomicAdd(&bar[XB_TMO], 1u); break; } }
    }
    nloc = mine > 0u ? mine : 1u; nx = cnt > 0u ? cnt : 1u;
}
__device__ __forceinline__ void xcd_barrier(const XcdBarrier& b) {
    asm volatile("s_waitcnt vmcnt(0)" ::: "memory");
    __syncthreads();
    if (threadIdx.x == 0) {
        unsigned* bar = b.bar;
        __builtin_amdgcn_s_waitcnt(0);
        unsigned nloc = b.st[0], nx = b.st[1];
        if (nloc == 0u) { xcd_barrier_complete(bar, b.x, nloc, nx); b.st[0] = nloc; b.st[1] = nx; }
        const unsigned old = xb_add(&bar[XB_XSUB(b.x)], 1u);
        const unsigned gen = old / nloc;
        if (old + 1u == (gen + 1u) * nloc) {
            __builtin_amdgcn_fence(__ATOMIC_RELEASE, "agent");
            asm volatile("s_waitcnt vmcnt(0)" ::: "memory");
            const unsigned og = xb_add(&bar[XB_TOP], 1u);
            const unsigned tg = og / nx;
            if (og + 1u == (tg + 1u) * nx) xb_add(&bar[XB_TOPGEN], 1u);
            else XB_SPIN(xb_ld(&bar[XB_TOPGEN]) == tg, bar);
            __builtin_amdgcn_fence(__ATOMIC_ACQUIRE, "agent");
            xb_add(&bar[XB_XGEN(b.x)], 1u);
            asm volatile("s_waitcnt vmcnt(0)" ::: "memory");
        } else {
            XB_SPIN(xb_ld(&bar[XB_XGEN(b.x)]) == gen, bar);
            __builtin_amdgcn_fence(__ATOMIC_ACQUIRE, "agent");
            asm volatile("s_waitcnt vmcnt(0)" ::: "memory");
        }
    }
    __syncthreads();
}

struct Args { const float* in[23]; float* out; unsigned char* ws; int ph_lo, ph_hi; };
struct Frame {
    LAS unsigned char* lds;
    int tid, lane, wave, vcu, G;
    const float* const* in;
    float* out; unsigned char* ws;
};
__device__ __forceinline__ void frame_ids(Frame& F) { int t = threadIdx.x; asm volatile("" : "+v"(t)); F.tid = t; F.lane = t & 63; F.wave = __builtin_amdgcn_readfirstlane(t >> 6); }
__device__ __forceinline__ float wave_sum(float v) {
#pragma unroll
    for (int o = 1; o < 64; o <<= 1) v += __shfl_xor(v, o);
    return v;
}
__device__ __forceinline__ void row_ln(f32x4 (&v)[4]) {
    float s = 0.f;
#pragma unroll
    for (int j = 0; j < 4; ++j) s += (v[j].x + v[j].y) + (v[j].z + v[j].w);
    const float mean = wave_sum(s) * (1.f / D); float s2 = 0.f;
#pragma unroll
    for (int j = 0; j < 4; ++j) { v[j] = v[j] - mean; s2 += (v[j].x * v[j].x + v[j].y * v[j].y) + (v[j].z * v[j].z + v[j].w * v[j].w); }
    const float rstd = 1.f / sqrtf(wave_sum(s2) * (1.f / D) + LN_EPS);
#pragma unroll
    for (int j = 0; j < 4; ++j) v[j] = v[j] * rstd;
}
__device__ __forceinline__ void row_load(f32x4 (&v)[4], const float* p, int lane) {
    const GAS f32x4* r = (const GAS f32x4*)p + lane;
#pragma unroll
    for (int j = 0; j < 4; ++j) v[j] = r[64 * j];
}
__device__ __forceinline__ void row_store(const f32x4 (&v)[4], float* p, int lane) {
    GAS f32x4* r = (GAS f32x4*)p + lane;
#pragma unroll
    for (int j = 0; j < 4; ++j) r[64 * j] = v[j];
}
__device__ __forceinline__ void row_store_bf16(const f32x4 (&v)[4], bf16* p, int lane) {
    GAS v2u* o = (GAS v2u*)p + lane;
#pragma unroll
    for (int j = 0; j < 4; ++j) { v2u w; w.x = pk2(v[j].x, v[j].y); w.y = pk2(v[j].z, v[j].w); o[64 * j] = w; }
}
__device__ __forceinline__ void row_load_bf16(f32x4 (&v)[4], const bf16* p, int lane) {
    const GAS v2u* r = (const GAS v2u*)p + lane;
#pragma unroll
    for (int j = 0; j < 4; ++j) { const v2u w = r[64 * j]; v[j] = (f32x4){bflo(w.x), bfhi(w.x), bflo(w.y), bfhi(w.y)}; }
}
__device__ __forceinline__ int tok_cond(int tok) { return tok < TLAT ? (tok >> 12) : NBATCH; }
__device__ __forceinline__ const float* x_input_row(const Frame& F, int tok) { return tok < TLAT ? F.in[0] + (size_t)tok * D : F.in[2] + (size_t)(tok - TLAT) * D; }

__device__ const double ROPE_INV[16] = {1.0, 0.5623413251903491, 0.31622776601683794, 0.1778279410038923, 0.1, 0.05623413251903491, 0.03162277660168379, 0.01778279410038923,
    0.01, 0.005623413251903491, 0.0031622776601683794, 0.0017782794100389228, 0.001, 0.0005623413251903491, 0.00031622776601683794, 0.00017782794100389227};
__device__ __forceinline__ void sincos_small(double a, double& s, double& c) {
    const double k = rint(a * 0.15915494309189535);
    double r = fma(-k, 6.283185307179586, a); r = fma(-k, 2.4492935982947064e-16, r);
    const double x = r * 0.125, x2 = x * x;
    double sn = x * (1.0 + x2 * (-1.0 / 6 + x2 * (1.0 / 120 + x2 * (-1.0 / 5040 + x2 * (1.0 / 362880 + x2 * (-1.0 / 39916800))))));
    double cs = 1.0 + x2 * (-0.5 + x2 * (1.0 / 24 + x2 * (-1.0 / 720 + x2 * (1.0 / 40320 + x2 * (-1.0 / 3628800 + x2 * (1.0 / 479001600))))));
#pragma unroll
    for (int i = 0; i < 3; ++i) { const double s2 = 2.0 * sn * cs, c2 = 1.0 - 2.0 * sn * sn; sn = s2; cs = c2; }
    s = sn; c = cs;
}
__device__ __forceinline__ void p0_transpose_item(const float* W, int K, int N, bf16* WT, int kb, int nb, int drow0, LAS float* scr, int lane) {
    const int k0 = 64 * kb, n0 = 32 * nb;
#pragma unroll 8
    for (int i = 0; i < 32; ++i) { const int kk = 2 * i + (lane >> 5); scr[kk * 33 + (lane & 31)] = W[(size_t)(k0 + kk) * N + n0 + (lane & 31)]; }
    LDS_WAIT(); asm volatile("" ::: "memory");
    const int c = lane & 7;
#pragma unroll
    for (int j = 0; j < 4; ++j) { const int n = (lane >> 3) + 8 * j; const LAS float* s = scr + (8 * c) * 33 + n;
        v4u o; o.x = pk2(s[0 * 33], s[1 * 33]); o.y = pk2(s[2 * 33], s[3 * 33]); o.z = pk2(s[4 * 33], s[5 * 33]); o.w = pk2(s[6 * 33], s[7 * 33]);
        *(GAS v4u*)(WT + (size_t)(drow0 + n) * K + k0 + 8 * c) = o; }
    LDS_WAIT(); asm volatile("" ::: "memory");
}
__device__ __forceinline__ void p0_prologue(Frame& F) {
    frame_ids(F);
    const float* c_in = F.in[1]; const float* cctx_in = F.in[3]; const float* w_mod = F.in[4]; const float* b_mod = F.in[5];
    float* MOD = (float*)(F.ws + WS_MOD);
    const int bx = blockIdx.x;
    for (int it = bx; it < DEPTH * 48; it += F.G) {
        LAS float* scond = (LAS float*)(F.lds);
        LAS float* red = (LAS float*)(F.lds + 36864);
        for (int i = F.tid; i < NCOND * D; i += NWAVES * 64) { const int n = i >> 10, k = i & 1023; const float cv = n < NBATCH ? c_in[n * D + k] : cctx_in[k];
            scond[i] = cv / (1.0f + expf(-cv)); }
        __syncthreads();
        const int l = it / 48, cb = it % 48;
        const float* wp = w_mod + ((size_t)l * D + F.wave * 128) * MODW + cb * 128 + 2 * F.lane;
        float acc[NCOND][2];
#pragma unroll
        for (int n = 0; n < NCOND; ++n) { acc[n][0] = 0.f; acc[n][1] = 0.f; }
#pragma unroll 8
        for (int kk = 0; kk < 128; ++kk) { const f32x2 wv = *(const GAS f32x2*)(wp + (size_t)kk * MODW);
#pragma unroll
            for (int n = 0; n < NCOND; ++n) { const float s = scond[n * D + F.wave * 128 + kk]; acc[n][0] += s * wv.x; acc[n][1] += s * wv.y; } }
#pragma unroll
        for (int n = 0; n < NCOND; ++n) { red[(F.wave * NCOND + n) * 128 + 2 * F.lane] = acc[n][0]; red[(F.wave * NCOND + n) * 128 + 2 * F.lane + 1] = acc[n][1]; }
        __syncthreads();
        for (int o = F.tid; o < NCOND * 128; o += NWAVES * 64) { const int n = o >> 7, cc = o & 127; float s = 0.f;
#pragma unroll
            for (int w = 0; w < NWAVES; ++w) s += red[(w * NCOND + n) * 128 + cc];
            MOD[((size_t)l * NCOND + n) * MODW + cb * 128 + cc] = s + b_mod[l * MODW + cb * 128 + cc]; }
        __syncthreads();
    }
    { float* COS = (float*)(F.ws + WS_COS); float* SIN = (float*)(F.ws + WS_SIN);
      for (int gt = bx * (NWAVES * 64) + F.tid; gt < SEQ * 32; gt += F.G * NWAVES * 64) { const int pos = gt >> 5, i = gt & 31; const int p = (i < 16) ? (pos >> 6) : (pos & 63);
          double s, c; sincos_small((double)p * ROPE_INV[i & 15], s, c); COS[gt] = (float)c; SIN[gt] = (float)s; } }
    { const float* sgu_w = F.in[10]; const float* pool_w = F.in[7]; bf16* SGUW = (bf16*)(F.ws + WS_SGUW); bf16* PWT = (bf16*)(F.ws + WS_PWT);
      for (int i = bx * (NWAVES * 64) + F.tid; i < DEPTH * 4 * 128 * 128; i += F.G * NWAVES * 64) SGUW[i] = (bf16)f2bf(sgu_w[i]);
      for (int i = bx * (NWAVES * 64) + F.tid; i < DEPTH * 4 * 64 * 64; i += F.G * NWAVES * 64) { const int lg = i >> 12, j = (i >> 6) & 63, ii = i & 63; PWT[i] = (bf16)f2bf(pool_w[(lg << 12) + ii * 64 + j]); } }
    LAS float* scr = (LAS float*)(F.lds + RING_OFF + F.wave * 16384);
    const int gw = F.vcu * NWAVES + F.wave, NGW = F.G * NWAVES;
    constexpr int I_IN = 16 * 48, I_OUT = 16 * 32, I_SQ = 16 * 32;
    constexpr int N_DENSE = DEPTH * (I_IN + I_OUT), N_MOE = DEPTH * NEXP * 3 * I_SQ;
    for (int it = gw; it < N_DENSE + N_MOE; it += NGW) {
        if (it < N_DENSE) {
            const int l = it / (I_IN + I_OUT); int r = it % (I_IN + I_OUT);
            if (r < I_IN) { const int kb = r / 48, nb = r % 48; p0_transpose_item(F.in[6] + (size_t)l * D * INW, D, INW, (bf16*)(F.ws + WS_WIN) + (size_t)l * INW * D, kb, nb, 32 * nb, scr, F.lane); }
            else { r -= I_IN; const int kb = r / 32, nb = r % 32; p0_transpose_item(F.in[14] + (size_t)l * D * D, D, D, (bf16*)(F.ws + WS_WOUT) + (size_t)l * D * D, kb, nb, 32 * nb, scr, F.lane); }
        } else {
            const int m = it - N_DENSE; const int le = m / (3 * I_SQ); int r = m % (3 * I_SQ); const int which = r / I_SQ; r %= I_SQ; const int kb = r / 32, nb = r % 32;
            if (which == 2) p0_transpose_item(F.in[20] + (size_t)le * D * D, D, D, (bf16*)(F.ws + WS_W2) + (size_t)le * D * D, kb, nb, 32 * nb, scr, F.lane);
            else { const int n0 = 32 * nb; const int drow0 = (n0 >> 7) * 256 + (n0 & 127) + (which == 1 ? 128 : 0);
                p0_transpose_item((which == 0 ? F.in[18] : F.in[19]) + (size_t)le * D * D, D, D, (bf16*)(F.ws + WS_W13) + (size_t)le * 2 * D * D, kb, nb, drow0, scr, F.lane); }
        }
    }
}

__device__ __forceinline__ void p1_mod_rows(Frame& F) {
    frame_ids(F);
    const float* MOD = (const float*)(F.ws + WS_MOD); bf16* H = (bf16*)(F.ws + WS_H);
    const int gw = F.vcu * NWAVES + F.wave, NGW = F.G * NWAVES;
    for (int tok = gw; tok < TTOK; tok += NGW) {
        f32x4 v[4]; row_load(v, x_input_row(F, tok), F.lane); row_ln(v);
        const float* md = MOD + (size_t)tok_cond(tok) * MODW;
        const GAS f32x4* sh = (const GAS f32x4*)(md) + F.lane; const GAS f32x4* sc = (const GAS f32x4*)(md + D) + F.lane;
#pragma unroll
        for (int j = 0; j < 4; ++j) v[j] = v[j] * (sc[64 * j] + 1.0f) + sh[64 * j];
        row_store_bf16(v, H + (size_t)tok * D, F.lane);
    }
}

template <int HALFW> __device__ __forceinline__ void pool_diff(const bf16* Zc  , int pos0, int L, int tg, LAS bf16* dP, int c) {
    float v[31];
#pragma unroll
    for (int j = 0; j < 31; ++j) { const int rel = 16 * tg - 8 + j; const int pos = pos0 + rel; v[j] = (pos >= 0 && pos < L) ? bf1(Zc[(long)rel * INW]) : 0.f; }
    float s = 0.f;
#pragma unroll
    for (int j = 8 - HALFW; j < 8 + HALFW; ++j) s += v[j];
#pragma unroll
    for (int i = 0; i < 16; ++i) {
        const int pos = pos0 + 16 * tg + i; const int hi = (pos + HALFW < L) ? pos + HALFW : L, lo = (pos - HALFW > 0) ? pos - HALFW : 0;
        const float d = s / (float)(hi - lo) - v[i + 8];
        dP[(16 * tg + i) * 72 + c] = (bf16)f2bf(d);
        if (i < 15) s += v[i + 8 + HALFW] - v[i + 8 - HALFW];
    }
}
__device__ __forceinline__ void pc_item(Frame& F, int l, int ck, int qt, bool kv_only) {
    const bf16* Z = (const bf16*)(F.ws + WS_Z); bf16* MIX = (bf16*)(F.ws + WS_MIX);
    const int tok0 = ck * 128; const bool isctx = tok0 >= TLAT;
    const int b = isctx ? ((tok0 - TLAT) >> 8) : (tok0 >> 12);
    const int pos0 = isctx ? ((tok0 - TLAT) & 255) : (tok0 & 4095);
    const int L = isctx ? CTXL : SEQ;
    const int tid = F.tid, lane = F.lane, wave = F.wave;
    LAS bf16* vT = (LAS bf16*)(F.lds);
    LAS bf16* dP = (LAS bf16*)(F.lds + 17408);
    if (!kv_only) {
        { const int h = qt, p = tid >> 2, dq = tid & 3;
          const GAS v4u* src = (const GAS v4u*)(Z + (size_t)(tok0 + p) * INW + OFF_V + h * 64 + 16 * dq);
          const v4u w0 = src[0], w1 = src[1]; float x[16];
          x[0] = bflo(w0.x); x[1] = bfhi(w0.x); x[2] = bflo(w0.y); x[3] = bfhi(w0.y); x[4] = bflo(w0.z); x[5] = bfhi(w0.z); x[6] = bflo(w0.w); x[7] = bfhi(w0.w);
          x[8] = bflo(w1.x); x[9] = bfhi(w1.x); x[10] = bflo(w1.y); x[11] = bfhi(w1.y); x[12] = bflo(w1.z); x[13] = bfhi(w1.z); x[14] = bflo(w1.w); x[15] = bfhi(w1.w);
          float s = 0.f;
#pragma unroll
          for (int i = 0; i < 16; ++i) { x[i] = gelu_tanh(x[i]); s += x[i]; }
          s += __shfl_xor(s, 1); s += __shfl_xor(s, 2);
          const float mean = s * (1.f / 64.f); float s2 = 0.f;
#pragma unroll
          for (int i = 0; i < 16; ++i) { x[i] -= mean; s2 += x[i] * x[i]; }
          s2 += __shfl_xor(s2, 1); s2 += __shfl_xor(s2, 2);
          const float rstd = 1.f / sqrtf(s2 * (1.f / 64.f) + LN_EPS);
          const float* gg = F.in[9] + ((size_t)l * 4 + h) * 64 + 16 * dq;
#pragma unroll
          for (int i = 0; i < 16; ++i) vT[(16 * dq + i) * 136 + p] = (bf16)f2bf(x[i] * rstd * gg[i]); }
        { const int g = qt, c = tid & 63, tg = tid >> 6; const bf16* Zc = Z + (size_t)tok0 * INW + OFF_POOL + g * 64 + c;
          if (g == 0) pool_diff<1>(Zc, pos0, L, tg, dP, c); else if (g == 1) pool_diff<2>(Zc, pos0, L, tg, dP, c); else if (g == 2) pool_diff<4>(Zc, pos0, L, tg, dP, c); else pool_diff<8>(Zc, pos0, L, tg, dP, c); }
        __syncthreads();
        { const int h = qt, fr = lane & 15, fq = lane >> 4, p = 16 * wave + fr;
          const bf16* SGUW = (const bf16*)(F.ws + WS_SGUW) + (((size_t)l * 4 + h) * 128 + p) * 128 + 8 * fq;
          bf16x8 wf[4];
#pragma unroll
          for (int ks = 0; ks < 4; ++ks) wf[ks] = *(const GAS bf16x8*)(SGUW + 32 * ks);
          f32x4 acc[4];
#pragma unroll
          for (int db = 0; db < 4; ++db) { acc[db] = (f32x4){0.f, 0.f, 0.f, 0.f};
#pragma unroll
              for (int ks = 0; ks < 4; ++ks) { const bf16x8 vf = *(const LAS bf16x8*)(vT + (16 * db + fr) * 136 + 32 * ks + 8 * fq);
                  acc[db] = __builtin_amdgcn_mfma_f32_16x16x32_bf16(vf, wf[ks], acc[db], 0, 0, 0); } }
          const float bias = F.in[11][((size_t)l * 4 + h) * 128 + p];
#pragma unroll
          for (int db = 0; db < 4; ++db) { const int d0 = 16 * db + 4 * fq;
              const v2u uw = *(const GAS v2u*)(Z + (size_t)(tok0 + p) * INW + OFF_U + h * 64 + d0);
              const float o0 = gelu_tanh(bflo(uw.x)) * (acc[db][0] + bias), o1 = gelu_tanh(bfhi(uw.x)) * (acc[db][1] + bias), o2 = gelu_tanh(bflo(uw.y)) * (acc[db][2] + bias), o3 = gelu_tanh(bfhi(uw.y)) * (acc[db][3] + bias);
              v2u ow; ow.x = pk2(o0, o1); ow.y = pk2(o2, o3);
              *(GAS v2u*)(MIX + (size_t)(tok0 + p) * D + 256 + h * 64 + d0) = ow; } }
        { const int g = qt, fr = lane & 15, fq = lane >> 4, p = 16 * wave + fr;
          const bf16* PWT = (const bf16*)(F.ws + WS_PWT) + ((size_t)l * 4 + g) * 4096;
          bf16x8 df[2];
#pragma unroll
          for (int ks = 0; ks < 2; ++ks) df[ks] = *(const LAS bf16x8*)(dP + p * 72 + 32 * ks + 8 * fq);
#pragma unroll
          for (int jb = 0; jb < 4; ++jb) { f32x4 acc = (f32x4){0.f, 0.f, 0.f, 0.f};
#pragma unroll
              for (int ks = 0; ks < 2; ++ks) { const bf16x8 pf = *(const GAS bf16x8*)(PWT + (16 * jb + fr) * 64 + 32 * ks + 8 * fq);
                  acc = __builtin_amdgcn_mfma_f32_16x16x32_bf16(pf, df[ks], acc, 0, 0, 0); }
              const int j0 = 16 * jb + 4 * fq; const f32x4 sc = *(const GAS f32x4*)(F.in[8] + (size_t)l * 256 + g * 64 + j0);
              v2u ow; ow.x = pk2(acc[0] * sc.x, acc[1] * sc.y); ow.y = pk2(acc[2] * sc.z, acc[3] * sc.w);
              *(GAS v2u*)(MIX + (size_t)(tok0 + p) * D + g * 64 + j0) = ow; } }
    }
    { bf16* Q = (bf16*)(F.ws + WS_Q); bf16* KB = (bf16*)(F.ws + WS_K); bf16* VB = (bf16*)(F.ws + WS_V);
      const float* COS = (const float*)(F.ws + WS_COS); const float* SIN = (const float*)(F.ws + WS_SIN);
      const int tt = (tid & 255) >> 3, sub = tid & 7; const int tok = tok0 + 32 * qt + tt; const int pos = pos0 + 32 * qt + tt;
      const size_t kvrow = (size_t)b * KVROWS + (isctx ? SEQ + pos : pos);
      f32x4 cs0 = (f32x4){1.f, 1.f, 1.f, 1.f}, cs1 = cs0, sn0 = (f32x4){0.f, 0.f, 0.f, 0.f}, sn1 = sn0;
      if (!isctx) { const GAS f32x4* cp = (const GAS f32x4*)(COS + (size_t)pos * 32 + 8 * (sub & 3)); const GAS f32x4* sp = (const GAS f32x4*)(SIN + (size_t)pos * 32 + 8 * (sub & 3));
          cs0 = cp[0]; cs1 = cp[1]; sn0 = sp[0]; sn1 = sp[1]; }
      const float cs[8] = {cs0.x, cs0.y, cs0.z, cs0.w, cs1.x, cs1.y, cs1.z, cs1.w}; const float sn[8] = {sn0.x, sn0.y, sn0.z, sn0.w, sn1.x, sn1.y, sn1.z, sn1.w};
#pragma unroll 1
      for (int ps = (kv_only ? 4 : 0); ps < 5; ++ps) {
          const int hs = 2 * ps + (tid >> 8);
          const bool isq = hs < 8;
          const int col = (isq ? OFF_Q + hs * 64 : OFF_K + (hs - 8) * 64) + 8 * sub;
          const v4u w = *(const GAS v4u*)(Z + (size_t)tok * INW + col);
          float x[8] = {bflo(w.x), bfhi(w.x), bflo(w.y), bfhi(w.y), bflo(w.z), bfhi(w.z), bflo(w.w), bfhi(w.w)};
          float ss = 0.f;
#pragma unroll
          for (int e = 0; e < 8; ++e) ss += x[e] * x[e];
          ss += __shfl_xor(ss, 1); ss += __shfl_xor(ss, 2); ss += __shfl_xor(ss, 4);
          const float r = 1.f / sqrtf(ss * (1.f / 64.f) + LN_EPS);
          const float* gp = (isq ? F.in[12] : F.in[13]) + (size_t)l * 64 + 8 * sub;
          float y[8], o[8];
#pragma unroll
          for (int e = 0; e < 8; ++e) y[e] = x[e] * r * gp[e];
#pragma unroll
          for (int e = 0; e < 8; ++e) { const float pr = __shfl_xor(y[e], 4); o[e] = (sub < 4) ? (y[e] * cs[e] - pr * sn[e]) : (y[e] * cs[e] + pr * sn[e]); }
          if (isq) {
#pragma unroll
              for (int e = 0; e < 8; ++e) o[e] *= 0.18033688011112042f;
          }
          v4u ow; ow.x = pk2(o[0], o[1]); ow.y = pk2(o[2], o[3]); ow.z = pk2(o[4], o[5]); ow.w = pk2(o[6], o[7]);
          if (isq) *(GAS v4u*)(Q + (size_t)tok * 512 + hs * 64 + 8 * sub) = ow;
          else *(GAS v4u*)(KB + kvrow * 128 + (hs - 8) * 64 + 8 * sub) = ow;
      }
      { const int t2 = tid >> 4, part = tid & 15; const int tk = tok0 + 32 * qt + t2; const int ps2 = pos0 + 32 * qt + t2;
        const size_t kr = (size_t)b * KVROWS + (isctx ? SEQ + ps2 : ps2);
        *(GAS v4u*)(VB + kr * 128 + 8 * part) = *(const GAS v4u*)(Z + (size_t)tk * INW + OFF_VAL + 8 * part); }
    }
    __syncthreads();
}

__device__ __forceinline__ void pf_rows(Frame& F, int l, bool last) {
    frame_ids(F);
    const float* MOD = (const float*)(F.ws + WS_MOD) + (size_t)l * NCOND * MODW;
    float* XB = (float*)(F.ws + WS_X); bf16* H = (bf16*)(F.ws + WS_H); const bf16* Y = (const bf16*)(F.ws + WS_Y); float* AFF = (float*)(F.ws + WS_AFF);
    LAS float* wrT = (LAS float*)(F.lds);
    { const float* wr = F.in[17] + (size_t)l * D * NEXP;
      for (int i = F.tid; i < D * NEXP; i += NWAVES * 64) { const int k = i >> 4, e = i & 15; wrT[e * D + k] = wr[i]; } }
    __syncthreads();
    const GAS f32x4* g1p = (const GAS f32x4*)(F.in[15] + (size_t)l * D) + F.lane; const GAS f32x4* b1p = (const GAS f32x4*)(F.in[16] + (size_t)l * D) + F.lane;
    const int gw = F.vcu * NWAVES + F.wave, NGW = F.G * NWAVES; const int ntok = last ? TLAT : TTOK;
    for (int tok = gw; tok < ntok; tok += NGW) {
        f32x4 v[4], y[4];
        row_load(v, l == 0 ? x_input_row(F, tok) : XB + (size_t)tok * D, F.lane);
        row_load_bf16(y, Y + (size_t)tok * D, F.lane);
        const float* md = MOD + (size_t)tok_cond(tok) * MODW;
        { const GAS f32x4* gp = (const GAS f32x4*)(md + 2 * D) + F.lane;
#pragma unroll
          for (int j = 0; j < 4; ++j) v[j] = v[j] * DN_ALPHA + gp[64 * j] * y[j]; }
        row_ln(v);
#pragma unroll
        for (int j = 0; j < 4; ++j) v[j] = v[j] * g1p[64 * j] + b1p[64 * j];
        row_store(v, XB + (size_t)tok * D, F.lane);
        row_ln(v);
        { const GAS f32x4* sh = (const GAS f32x4*)(md + 3 * D) + F.lane; const GAS f32x4* sc = (const GAS f32x4*)(md + 4 * D) + F.lane;
#pragma unroll
          for (int j = 0; j < 4; ++j) v[j] = v[j] * (sc[64 * j] + 1.0f) + sh[64 * j]; }
        row_store_bf16(v, H + (size_t)tok * D, F.lane);
        float lgm = -3.0e38f;
#pragma unroll 1
        for (int e = 0; e < NEXP; ++e) { float a = 0.f;
#pragma unroll
            for (int j = 0; j < 4; ++j) { const f32x4 w = *(const LAS f32x4*)(wrT + e * D + 256 * j + 4 * F.lane); a += (v[j].x * w.x + v[j].y * w.y) + (v[j].z * w.z + v[j].w * w.w); }
            a = wave_sum(a); lgm = (F.lane == e) ? a : lgm; }
        float mx = lgm;
#pragma unroll
        for (int o = 1; o < 16; o <<= 1) mx = fmaxf(mx, __shfl_xor(mx, o));
        const float ex = (F.lane < NEXP) ? expf(lgm - mx) : 0.f; float sum = ex;
#pragma unroll
        for (int o = 1; o < 16; o <<= 1) sum += __shfl_xor(sum, o);
        const float mine = ex / sum;
        if (F.lane < NEXP) AFF[(size_t)tok * NEXP + F.lane] = mine;
    }
    __syncthreads();
}

__device__ __forceinline__ void pg_item(Frame& F, int s, int e) {
    const float* AFF = (const float*)(F.ws + WS_AFF); int* ROWIDX = (int*)(F.ws + WS_ROWIDX); float* GATE = (float*)(F.ws + WS_GATE); int* INV = (int*)(F.ws + WS_INV);
    const bool isctx = s >= NBATCH; const int n = isctx ? CTXL : SEQ, cap = isctx ? CAP_C : CAP_L;
    const int tok0 = isctx ? TLAT + (s - NBATCH) * CTXL : s * SEQ;
    const int sbase = isctx ? NBATCH * CAP_L + (s - NBATCH) * CAP_C : s * CAP_L;
    LAS unsigned* hist = (LAS unsigned*)(F.lds);
    LAS unsigned* sel = (LAS unsigned*)(F.lds + 1024);
    LAS unsigned* wtot = (LAS unsigned*)(F.lds + 1088);
    const int tid = F.tid, lane = F.lane;
    unsigned bits[8];
#pragma unroll
    for (int i = 0; i < 8; ++i) { const int idx = 8 * tid + i; bits[i] = idx < n ? __builtin_bit_cast(unsigned, AFF[(size_t)(tok0 + idx) * NEXP + e]) : 0u; }
    unsigned prefix = 0u, krem = (unsigned)cap;
#pragma unroll 1
    for (int pass = 0; pass < 4; ++pass) {
        const int shift = 24 - 8 * pass;
        if (tid < 256) hist[tid] = 0u;
        __syncthreads();
#pragma unroll
        for (int i = 0; i < 8; ++i) { const bool valid = (8 * tid + i) < n; const bool match = (pass == 0) ? true : ((bits[i] >> (shift + 8)) == prefix);
            if (valid && match) __hip_atomic_fetch_add(&hist[(bits[i] >> shift) & 255u], 1u, __ATOMIC_RELAXED, __HIP_MEMORY_SCOPE_WORKGROUP); }
        __syncthreads();
        if (tid < 64) {
            unsigned c[4]; unsigned tot = 0u;
#pragma unroll
            for (int j = 0; j < 4; ++j) { c[j] = hist[255 - 4 * lane - j]; tot += c[j]; }
            unsigned incl = tot;
#pragma unroll
            for (int o = 1; o < 64; o <<= 1) { const unsigned t = __shfl_up(incl, o); if (lane >= o) incl += t; }
            unsigned run = incl - tot;
#pragma unroll
            for (int j = 0; j < 4; ++j) { if (run < krem && run + c[j] >= krem) { sel[0] = (unsigned)(255 - 4 * lane - j); sel[1] = krem - run; } run += c[j]; }
        }
        __syncthreads();
        prefix = (prefix << 8) | sel[0]; krem = sel[1];
        __syncthreads();
    }
    const unsigned thr = prefix;
    unsigned loc = 0u;
#pragma unroll
    for (int i = 0; i < 8; ++i) { const bool valid = (8 * tid + i) < n; loc += (valid && bits[i] > thr) ? 1u : 0u; loc += (valid && bits[i] == thr) ? 0x10000u : 0u; }
    unsigned incl = loc;
#pragma unroll
    for (int o = 1; o < 64; o <<= 1) { const unsigned t = __shfl_up(incl, o); if (lane >= o) incl += t; }
    if (lane == 63) wtot[F.wave] = incl;
    __syncthreads();
    unsigned before = incl - loc;
#pragma unroll
    for (int w = 0; w < NWAVES; ++w) before += (w < F.wave) ? wtot[w] : 0u;
#pragma unroll
    for (int i = 0; i < 8; ++i) { const int idx = 8 * tid + i;
        if (idx < n) { const unsigned g = before & 0xffffu, q = before >> 16; const bool gt = bits[i] > thr, eq = bits[i] == thr;
            int slot = -1;
            if (gt) slot = (int)(g + (q < krem ? q : krem)); else if (eq && q < krem) slot = (int)(g + q);
            const int tok = tok0 + idx;
            if (slot >= 0) { ROWIDX[(size_t)e * EROWS + sbase + slot] = tok; GATE[(size_t)e * EROWS + sbase + slot] = __builtin_bit_cast(float, bits[i]); }
            INV[(size_t)tok * NEXP + e] = slot >= 0 ? sbase + slot : -1;
            before += gt ? 1u : 0u; before += eq ? 0x10000u : 0u; } }
    __syncthreads();
}

__device__ __forceinline__ void pj_rows(Frame& F, int l, bool last) {
    frame_ids(F);
    const float* MOD = (const float*)(F.ws + WS_MOD) + (size_t)l * NCOND * MODW;
    float* XB = (float*)(F.ws + WS_X); bf16* H = (bf16*)(F.ws + WS_H); const bf16* YE = (const bf16*)(F.ws + WS_YEXP); const int* INV = (const int*)(F.ws + WS_INV);
    const GAS f32x4* g2p = (const GAS f32x4*)(F.in[21] + (size_t)l * D) + F.lane; const GAS f32x4* b2p = (const GAS f32x4*)(F.in[22] + (size_t)l * D) + F.lane;
    const int gw = F.vcu * NWAVES + F.wave, NGW = F.G * NWAVES; const int ntok = last ? TLAT : TTOK;
    for (int tok = gw; tok < ntok; tok += NGW) {
        const int invv = INV[(size_t)tok * NEXP + (F.lane & 15)];
        f32x4 ml[4];
#pragma unroll
        for (int j = 0; j < 4; ++j) ml[j] = (f32x4){0.f, 0.f, 0.f, 0.f};
#pragma unroll
        for (int e = 0; e < NEXP; ++e) { const int slot = __builtin_amdgcn_readlane(invv, e);
            if (slot >= 0) { f32x4 y[4]; row_load_bf16(y, YE + ((size_t)e * EROWS + slot) * D, F.lane);
#pragma unroll
                for (int j = 0; j < 4; ++j) ml[j] = ml[j] + y[j]; } }
        f32x4 v[4]; row_load(v, XB + (size_t)tok * D, F.lane);
        const float* md = MOD + (size_t)tok_cond(tok) * MODW;
        { const GAS f32x4* gp = (const GAS f32x4*)(md + 5 * D) + F.lane;
#pragma unroll
          for (int j = 0; j < 4; ++j) v[j] = v[j] * DN_ALPHA + gp[64 * j] * ml[j]; }
        row_ln(v);
#pragma unroll
        for (int j = 0; j < 4; ++j) v[j] = v[j] * g2p[64 * j] + b2p[64 * j];
        if (last) { row_store(v, F.out + (size_t)tok * D, F.lane); }
        else {
            row_store(v, XB + (size_t)tok * D, F.lane);
            row_ln(v);
            const float* mdn = md + (size_t)NCOND * MODW;
            const GAS f32x4* sh = (const GAS f32x4*)(mdn) + F.lane; const GAS f32x4* sc = (const GAS f32x4*)(mdn + D) + F.lane;
#pragma unroll
            for (int j = 0; j < 4; ++j) v[j] = v[j] * (sc[64 * j] + 1.0f) + sh[64 * j];
            row_store_bf16(v, H + (size_t)tok * D, F.lane);
        }
    }
}

constexpr int NPHASE = 2 + 9 * DEPTH;
__global__ void __launch_bounds__(NWAVES * 64, 2) fwd_kernel(Args args) {
    extern __shared__ __attribute__((aligned(16))) unsigned char lds[];
    Frame F;
    F.lds = (LAS unsigned char*)lds;
    F.tid = threadIdx.x; F.lane = F.tid & 63; F.wave = __builtin_amdgcn_readfirstlane(F.tid >> 6);
    F.G = gridDim.x; { const int bx = blockIdx.x; F.vcu = (F.G % 8 == 0) ? (bx % 8) * (F.G / 8) + bx / 8 : bx; }
    F.in = args.in; F.out = args.out; F.ws = args.ws;
    volatile LAS unsigned* MISC = (volatile LAS unsigned*)(F.lds + MISC_OFF);
    for (int u = F.tid; u < (LDS_BYTES - LDSCTL_OFF) / 4; u += NWAVES * 64) ((LAS unsigned*)(F.lds + LDSCTL_OFF))[u] = 0u;
    __syncthreads();
    XcdBarrier bar; bar.bar = (unsigned*)(args.ws + WS_CTL) + CW_BAR; bar.x = 0; bar.st = nullptr;
#if !MK_PER_PHASE
    bar = xcd_barrier_post((unsigned*)(args.ws + WS_CTL) + CW_BAR, MISC + 8);
#endif
    const int lo = args.ph_lo, hi = args.ph_hi;
#define IN(k) (lo <= (k) && (k) < hi)
#if MK_PER_PHASE
#define SEAM(k) do { } while (0)
#else
#define SEAM(k) do { if (IN((k) + 1)) xcd_barrier(bar); } while (0)
#endif
    if (IN(0)) { p0_prologue(F); SEAM(0); }
    if (IN(1)) { p1_mod_rows(F); SEAM(1); }
#pragma unroll 1
    for (int l = 0; l < DEPTH; ++l) {
        const int pb = 2 + 9 * l; const bool last = (l == DEPTH - 1);
        if (IN(pb + 0)) {
            pg8::DenseOrder S; S.A = (const bf16*)(F.ws + WS_H); S.Bt = (const bf16*)(F.ws + WS_WIN) + (size_t)l * INW * D; S.K = D; S.nN = INW / 256; S.G = F.G; S.c = (int)blockIdx.x;
            if (last) { S.nM = TLAT / 256; S.extra_pm0 = TLAT / 256; S.n_extra = TCTX / 256; S.extra_pn = 5; } else { S.nM = TTOK / 256; S.extra_pm0 = 0; S.n_extra = 0; S.extra_pn = 0; }
            S.nwg = S.nM * S.nN;
            pg8::EpiBf16Plain E{(bf16*)(F.ws + WS_Z), INW};
            pg8::gemm_phase<pg8::EpiBf16Plain, pg8::DenseOrder, true>(F.lds + RING_OFF, S, E);
            SEAM(pb + 0);
        }
        if (IN(pb + 1)) {
            frame_ids(F);
            const int nlat = (TLAT / 128) * 4, nall = (TTOK / 128) * 4;
            for (int it = F.vcu; it < nall; it += F.G) pc_item(F, l, it >> 2, it & 3, last && it >= nlat);
            SEAM(pb + 1);
        }
        if (IN(pb + 2)) {
            const attn_body::bf16* Q = (const attn_body::bf16*)(F.ws + WS_Q); const attn_body::bf16* KB = (const attn_body::bf16*)(F.ws + WS_K); const attn_body::bf16* VB = (const attn_body::bf16*)(F.ws + WS_V);
            attn_body::bf16* MIX = (attn_body::bf16*)(F.ws + WS_MIX);
            const int nun = last ? 1024 : 1024 + 64;
            for (int L = F.vcu; L < nun; L += F.G) {
                if (L < 1024) { const int i = L >> 8, v = L & 255, x = v >> 5, j = v & 31; const int b = x, kvh = i >> 1, h = kvh * 4 + (j & 3), qb = (i & 1) * 8 + (j >> 2);
                    attn_body::attn_unit<8>(Q + ((size_t)b * SEQ + qb * 256) * 512 + h * 64, KB + (size_t)b * KVROWS * 128 + kvh * 64, VB + (size_t)b * KVROWS * 128 + kvh * 64,
                                            MIX + ((size_t)b * SEQ + qb * 256) * D + 512 + h * 64, KVROWS / 64, (char*)lds + RING_OFF); }
                else { const int c = L - 1024, b = c >> 3, h = c & 7, kvh = h >> 2;
                    attn_body::attn_unit<8>(Q + ((size_t)TLAT + b * CTXL) * 512 + h * 64, KB + ((size_t)b * KVROWS + SEQ) * 128 + kvh * 64, VB + ((size_t)b * KVROWS + SEQ) * 128 + kvh * 64,
                                            MIX + ((size_t)TLAT + b * CTXL) * D + 512 + h * 64, CTXL / 64, (char*)lds + RING_OFF); }
            }
            SEAM(pb + 2);
        }
        if (IN(pb + 3)) {
            pg8::DenseOrder S; S.A = (const bf16*)(F.ws + WS_MIX); S.Bt = (const bf16*)(F.ws + WS_WOUT) + (size_t)l * D * D; S.K = D; S.nN = D / 256; S.G = F.G; S.c = (int)blockIdx.x;
            S.nM = (last ? TLAT : TTOK) / 256; S.extra_pm0 = 0; S.n_extra = 0; S.extra_pn = 0; S.nwg = S.nM * S.nN;
            pg8::EpiBf16Plain E{(bf16*)(F.ws + WS_Y), D};
            pg8::gemm_phase<pg8::EpiBf16Plain, pg8::DenseOrder, true>(F.lds + RING_OFF, S, E);
            SEAM(pb + 3);
        }
        if (IN(pb + 4)) { pf_rows(F, l, last); SEAM(pb + 4); }
        if (IN(pb + 5)) {
            frame_ids(F);
            const int nit = (last ? NBATCH : 2 * NBATCH) * NEXP;
            for (int it = F.vcu; it < nit; it += F.G) pg_item(F, it >> 4, it & 15);
            SEAM(pb + 5);
        }
        if (IN(pb + 6)) {
            pg8::MoeOrder<true> S; S.A = (const bf16*)(F.ws + WS_H); S.Bt = (const bf16*)(F.ws + WS_W13) + (size_t)l * NEXP * 2 * D * D; S.rowidx = (const int*)(F.ws + WS_ROWIDX);
            S.K = D; S.nRT = last ? 16 : 17; S.nPN = 8; S.ERP = EROWS; S.BRP = 2 * D; S.nwg = NEXP * S.nRT * S.nPN; S.G = F.G; S.c = (int)blockIdx.x;
            pg8::EpiSwiglu E{(bf16*)(F.ws + WS_HID), EROWS};
            pg8::gemm_phase<pg8::EpiSwiglu, pg8::MoeOrder<true>, true>(F.lds + RING_OFF, S, E);
            SEAM(pb + 6);
        }
        if (IN(pb + 7)) {
            pg8::MoeOrder<false> S; S.A = (const bf16*)(F.ws + WS_HID); S.Bt = (const bf16*)(F.ws + WS_W2) + (size_t)l * NEXP * D * D; S.rowidx = nullptr;
            S.K = D; S.nRT = last ? 16 : 17; S.nPN = 4; S.ERP = EROWS; S.BRP = D; S.nwg = NEXP * S.nRT * S.nPN; S.G = F.G; S.c = (int)blockIdx.x;
            pg8::EpiGate E{(bf16*)(F.ws + WS_YEXP), (const float*)(F.ws + WS_GATE), EROWS};
            pg8::gemm_phase<pg8::EpiGate, pg8::MoeOrder<false>, true>(F.lds + RING_OFF, S, E);
            SEAM(pb + 7);
        }
        if (IN(pb + 8)) { pj_rows(F, l, last); if (!last) SEAM(pb + 8); }
    }
#undef IN
#undef SEAM
}

extern "C" void kernel_launch(void* const* d_in, const int* in_sizes, int n_in, void* d_out, int out_size, void* d_ws, size_t ws_size, hipStream_t stream) {
    static int grid = 0;
    if (grid == 0) {
        if (n_in != 23 || in_sizes[0] != TLAT * D || out_size != TLAT * D || ws_size < WS_END) { fprintf(stderr, "kernel_launch: unexpected shapes / workspace (n_in %d, ws %zu); nothing launched\n", n_in, ws_size); grid = -1; return; }
        int dev = 0, cus = 0, per_cu = 0;
        if (hipGetDevice(&dev) != hipSuccess || hipDeviceGetAttribute(&cus, hipDeviceAttributeMultiprocessorCount, dev) != hipSuccess) { grid = -1; return; }
        if (hipFuncSetAttribute((const void*)fwd_kernel, hipFuncAttributeMaxDynamicSharedMemorySize, LDS_BYTES) != hipSuccess) { fprintf(stderr, "kernel_launch: hipFuncSetAttribute failed\n"); grid = -1; return; }
        if (hipOccupancyMaxActiveBlocksPerMultiprocessor(&per_cu, (const void*)fwd_kernel, NWAVES * 64, LDS_BYTES) != hipSuccess || per_cu < 1) { fprintf(stderr, "kernel_launch: occupancy query says %d\n", per_cu); }
        (void)hipGetLastError();
        grid = cus;
    }
    if (grid < 0) return;
    if (hipMemsetAsync((char*)d_ws + WS_CTL, 0, CTL_ZERO_BYTES, stream) != hipSuccess) return;
    Args a{};
    for (int i = 0; i < 23; ++i) a.in[i] = (const float*)d_in[i];
    a.out = (float*)d_out; a.ws = (unsigned char*)d_ws;
#if MK_PER_PHASE
    for (int p = 0; p < NPHASE; ++p) { a.ph_lo = p; a.ph_hi = p + 1; hipLaunchKernelGGL(fwd_kernel, dim3(grid), dim3(NWAVES * 64), LDS_BYTES, stream, a); }
#else
    a.ph_lo = 0; a.ph_hi = NPHASE; hipLaunchKernelGGL(fwd_kernel, dim3(grid), dim3(NWAVES * 64), LDS_BYTES, stream, a);
#endif
}
```

```cpp
#include <hip/hip_runtime.h>
#include <cstdio>
#include <cstdint>

#ifndef MK_PER_PHASE
#define MK_PER_PHASE 0
#endif

namespace pg8 {
#define PG8_LAS __attribute__((address_space(3)))
typedef unsigned short bf16_t;
typedef short bf16x8 __attribute__((ext_vector_type(8)));
typedef float f32x4 __attribute__((ext_vector_type(4)));
typedef unsigned u32x4 __attribute__((ext_vector_type(4)));
constexpr int BM = 256, BK = 64, HALF = 128, HTB = HALF * BK * 2  , STAGE_BYTES = 8 * HTB, NXCD = 8, WGM = 8;

__host__ __device__ __forceinline__ int lds_byte(int r, int c) { const int st = (r >> 4) * 2 + (c >> 5), rr = r & 15, cc = c & 31, ob = rr * 64 + cc * 2; return st * 1024 + (ob ^ (((ob >> 9) & 1) << 5)); }
__host__ __device__ __forceinline__ void stage_rc(int b, int& R, int& C) { const int st = b / 1024, sb = b % 1024, swz = sb ^ (((sb >> 9) & 1) << 5); R = (st >> 1) * 16 + swz / 64; C = (st & 1) * 32 + (swz % 64) / 2; }
__host__ __device__ __forceinline__ int perm32(int rho) { const int n = rho >> 4, i = rho & 15; return 8 * (i >> 2) + 4 * n + (i & 3); }

struct Unit { int pm, pn, e; };

__device__ __forceinline__ void xcd_remap(int& wgid, int nwg) { const int q = nwg / NXCD, r = nwg % NXCD, xcd = wgid % NXCD, off = wgid / NXCD; wgid = (xcd < r ? xcd * (q + 1) : r * (q + 1) + (xcd - r) * q) + off; }

struct DenseOrder {
    static constexpr bool GATHER = false;
    const bf16_t* A; const bf16_t* Bt; int K, nM, nN, nwg, G, c, extra_pm0, n_extra, extra_pn;
    __device__ __forceinline__ bool next(int i, Unit& u) const {
        const int L = i * G + c; u.e = 0;
        if (L >= nwg) { const int x = L - nwg; if (x >= n_extra) return false; u.pm = extra_pm0 + x; u.pn = extra_pn; return true; }
        int wgid = L; xcd_remap(wgid, nwg);
        const int nig = WGM * nN, gid = wgid / nig, fm = gid * WGM, gsz = (nM - fm) < WGM ? (nM - fm) : WGM;
        u.pm = fm + ((wgid % nig) % gsz); u.pn = (wgid % nig) / gsz; return true;
    }
    __device__ __forceinline__ const char* a_base(const Unit& u) const { return (const char*)(A + (size_t)u.pm * BM * K); }
    __device__ __forceinline__ const char* b_base(const Unit& u) const { return (const char*)(Bt + (size_t)u.pn * BM * K); }
    __device__ __forceinline__ const int* a_rows(const Unit&) const { return nullptr; }
};
template <bool GATHER_> struct MoeOrder {
    static constexpr bool GATHER = GATHER_;
    const bf16_t* A; const bf16_t* Bt; const int* rowidx; int K, nRT, nPN, ERP  , BRP  , nwg, G, c;
    __device__ __forceinline__ bool next(int i, Unit& u) const {
        const int L = i * G + c; if (L >= nwg) return false;
        int wgid = L; xcd_remap(wgid, nwg);
        const int per = nRT * nPN; u.e = wgid / per; const int rem = wgid % per; u.pm = rem / nPN; u.pn = rem % nPN; return true;
    }
    __device__ __forceinline__ const char* a_base(const Unit& u) const { return GATHER ? (const char*)A : (const char*)(A + ((size_t)u.e * ERP + (size_t)u.pm * BM) * K); }
    __device__ __forceinline__ const char* b_base(const Unit& u) const { return (const char*)(Bt + ((size_t)u.e * BRP + (size_t)u.pn * BM) * K); }
    __device__ __forceinline__ const int* a_rows(const Unit& u) const { return rowidx + (size_t)u.e * ERP + (size_t)u.pm * BM; }
};

__device__ __forceinline__ unsigned cvt_pk_bf16(float lo, float hi) { unsigned r; asm volatile("v_cvt_pk_bf16_f32 %0, %1, %2" : "=v"(r) : "v"(lo), "v"(hi)); return r; }

struct EpiBf16Plain {
    static constexpr bool PERM = true;
    bf16_t* O; int ldc;
    __device__ __forceinline__ void operator()(const f32x4 (&acc)[2][2][4][2], const Unit& u, int wr, int wc, int fr, int fq) const {
        const int row0 = u.pm * BM + wr * 64 + fr, col0 = u.pn * BM + wc * 32 + 8 * fq;
#pragma unroll
        for (int ai = 0; ai < 2; ++ai)
#pragma unroll
            for (int m = 0; m < 4; ++m) { bf16_t* rowp = O + (size_t)(row0 + ai * HALF + m * 16) * ldc + col0;
#pragma unroll
                for (int bj = 0; bj < 2; ++bj) { const f32x4 v0 = acc[ai][bj][m][0], v1 = acc[ai][bj][m][1];
                    u32x4 w; w.x = cvt_pk_bf16(v0[0], v0[1]); w.y = cvt_pk_bf16(v0[2], v0[3]); w.z = cvt_pk_bf16(v1[0], v1[1]); w.w = cvt_pk_bf16(v1[2], v1[3]);
                    *(u32x4*)(rowp + bj * HALF) = w; } }
    }
};
__device__ __forceinline__ float silu_f(float a) { return a * __builtin_amdgcn_rcpf(1.0f + __builtin_amdgcn_exp2f(-1.4426950408889634f * a)); }
struct EpiSwiglu {
    static constexpr bool PERM = true;
    bf16_t* O; int ERP;
    __device__ __forceinline__ void operator()(const f32x4 (&acc)[2][2][4][2], const Unit& u, int wr, int wc, int fr, int fq) const {
        const size_t row0 = (size_t)u.e * ERP + (size_t)u.pm * BM + wr * 64 + fr; const int col0 = u.pn * HALF + wc * 32 + 8 * fq;
#pragma unroll
        for (int ai = 0; ai < 2; ++ai)
#pragma unroll
            for (int m = 0; m < 4; ++m) { bf16_t* rowp = O + (row0 + ai * HALF + m * 16) * 1024 + col0;
                const f32x4 a0 = acc[ai][0][m][0], a1 = acc[ai][0][m][1], b0 = acc[ai][1][m][0], b1 = acc[ai][1][m][1];
                u32x4 w; w.x = cvt_pk_bf16(silu_f(a0[0]) * b0[0], silu_f(a0[1]) * b0[1]); w.y = cvt_pk_bf16(silu_f(a0[2]) * b0[2], silu_f(a0[3]) * b0[3]);
                w.z = cvt_pk_bf16(silu_f(a1[0]) * b1[0], silu_f(a1[1]) * b1[1]); w.w = cvt_pk_bf16(silu_f(a1[2]) * b1[2], silu_f(a1[3]) * b1[3]);
                *(u32x4*)rowp = w; }
    }
};
struct EpiGate {
    static constexpr bool PERM = true;
    bf16_t* O; const float* gate; int ERP;
    __device__ __forceinline__ void operator()(const f32x4 (&acc)[2][2][4][2], const Unit& u, int wr, int wc, int fr, int fq) const {
        const size_t row0 = (size_t)u.e * ERP + (size_t)u.pm * BM + wr * 64 + fr; const int col0 = u.pn * BM + wc * 32 + 8 * fq;
#pragma unroll
        for (int ai = 0; ai < 2; ++ai)
#pragma unroll
            for (int m = 0; m < 4; ++m) { const size_t row = row0 + ai * HALF + m * 16; bf16_t* rowp = O + row * 1024 + col0; const float gt = gate[row];
#pragma unroll
                for (int bj = 0; bj < 2; ++bj) { const f32x4 v0 = acc[ai][bj][m][0] * gt, v1 = acc[ai][bj][m][1] * gt;
                    u32x4 w; w.x = cvt_pk_bf16(v0[0], v0[1]); w.y = cvt_pk_bf16(v0[2], v0[3]); w.z = cvt_pk_bf16(v1[0], v1[1]); w.w = cvt_pk_bf16(v1[2], v1[3]);
                    *(u32x4*)(rowp + bj * HALF) = w; } }
    }
};

template <class Epi, class Sched, bool ALIGN_EPI>
__device__ __forceinline__ void gemm_phase(PG8_LAS unsigned char* lds, const Sched& S, const Epi& E) {
    int tid_ = threadIdx.x; asm volatile("" : "+v"(tid_));
    const int tid = tid_, wid = __builtin_amdgcn_readfirstlane(tid >> 6), lane = tid & 63, wr = wid >> 2, wc = wid & 3, fr = lane & 15, fq = lane >> 4;
    const int K = S.K, nt = K / BK;
    constexpr bool GA = Sched::GATHER;
    unsigned voffB[2]; int Rst[2]; unsigned Cst[2];
    unsigned curA[2][2], nxtA[2][2];
    const size_t hstep = (size_t)HALF * K * 2;
#pragma unroll
    for (int i = 0; i < 2; ++i) { int R, C; stage_rc(tid * 16 + i * 8192, R, C); const int Rb = Epi::PERM ? ((R & ~31) + perm32(R & 31)) : R;
        Rst[i] = R; Cst[i] = (unsigned)C * 2u; voffB[i] = (unsigned)(Rb * K + C) * 2u;
#pragma unroll
        for (int h = 0; h < 2; ++h) { curA[h][i] = (unsigned)((h * HALF + R) * K + C) * 2u; nxtA[h][i] = curA[h][i]; } }
    const size_t kstep = (size_t)(BK * 2);
    const unsigned ldsw = (unsigned)wid * 1024u;
    const int aoff = lds_byte(wr * 64 + fr, fq * 8), boff = lds_byte(wc * 32 + fr, fq * 8);
#define PG8_SA(b, h) (((b) * 2 + (h)) * HTB)
#define PG8_SB(b, h) ((4 + (b) * 2 + (h)) * HTB)
#define PG8_STAGE(bufoff, gbase, voff) do { _Pragma("unroll") for (int _i = 0; _i < 2; ++_i) \
        __builtin_amdgcn_global_load_lds((const unsigned*)((const char*)(gbase) + (voff)[_i]), (PG8_LAS unsigned*)(lds + (bufoff) + ldsw + _i * 8192), 16, 0, 0); } while (0)
#define PG8_LDA(dst, b, h) do { _Pragma("unroll") for (int m = 0; m < 4; ++m) _Pragma("unroll") for (int k = 0; k < 2; ++k) dst[m][k] = *(const PG8_LAS bf16x8*)(lds + PG8_SA(b, h) + aoff + m * 2048 + k * 1024); } while (0)
#define PG8_LDB(dst, b, h) do { _Pragma("unroll") for (int n = 0; n < 2; ++n) _Pragma("unroll") for (int k = 0; k < 2; ++k) dst[n][k] = *(const PG8_LAS bf16x8*)(lds + PG8_SB(b, h) + boff + n * 2048 + k * 1024); } while (0)
#define PG8_MMA(ai, bj, At, Bt) do { __builtin_amdgcn_s_setprio(1); _Pragma("unroll") for (int m = 0; m < 4; ++m) _Pragma("unroll") for (int n = 0; n < 2; ++n) _Pragma("unroll") for (int k = 0; k < 2; ++k) \
        acc[ai][bj][m][n] = __builtin_amdgcn_mfma_f32_16x16x32_bf16(Bt[n][k], At[m][k], acc[ai][bj][m][n], 0, 0, 0); __builtin_amdgcn_s_setprio(0); } while (0)
#define PG8_WAIT_V(n) asm volatile("s_waitcnt vmcnt(" #n ")" ::: "memory")
#define PG8_WAIT_L(n) asm volatile("s_waitcnt lgkmcnt(" #n ")" ::: "memory")
#define PG8_BAR __builtin_amdgcn_s_barrier()
#define PG8_SCHED __builtin_amdgcn_sched_barrier(0)
#define PG8_ROWS(dst, u) do { if constexpr (GA) { const int* _rw = S.a_rows(u); _Pragma("unroll") for (int _h = 0; _h < 2; ++_h) _Pragma("unroll") for (int _i = 0; _i < 2; ++_i) \
        dst[_h][_i] = (unsigned)_rw[_h * HALF + Rst[_i]] * (unsigned)(K * 2) + Cst[_i]; } } while (0)
    Unit cur, nxt; int ui = 0;
    if (!S.next(0, cur)) return;
    f32x4 acc[2][2][4][2];
#pragma unroll
    for (int a = 0; a < 2; ++a)
#pragma unroll
        for (int b = 0; b < 2; ++b)
#pragma unroll
            for (int m = 0; m < 4; ++m)
#pragma unroll
                for (int n = 0; n < 2; ++n) acc[a][b][m][n] = (f32x4){0.f, 0.f, 0.f, 0.f};
    bf16x8 At[4][2], B0[2][2], B1[2][2];
    const char* cA = S.a_base(cur); const char* cB = S.b_base(cur);
    PG8_ROWS(curA, cur);
    PG8_STAGE(PG8_SB(0, 0), cB, voffB); PG8_STAGE(PG8_SB(0, 1), cB + hstep, voffB); PG8_STAGE(PG8_SA(0, 0), cA, curA[0]); PG8_STAGE(PG8_SA(0, 1), cA, curA[1]);
    if (wr == 1) PG8_BAR;
    PG8_WAIT_V(2); PG8_BAR;
    PG8_STAGE(PG8_SB(1, 0), cB + kstep, voffB); PG8_STAGE(PG8_SA(1, 0), cA + kstep, curA[0]); PG8_STAGE(PG8_SB(1, 1), cB + hstep + kstep, voffB);
    PG8_WAIT_V(6); PG8_BAR;
    for (;;) {
        const bool has_next = S.next(ui + 1, nxt);
        const char* nA = has_next ? S.a_base(nxt) : cA; const char* nB = has_next ? S.b_base(nxt) : cB;
        for (int t = 0; t < nt; t += 2) {
            const bool last = (t == nt - 2);
            const char* a1 = cA + (size_t)(t + 1) * kstep;
            const char* a2 = last ? nA : cA + (size_t)(t + 2) * kstep; const char* b2 = last ? nB : cB + (size_t)(t + 2) * kstep;
            const char* a3 = a2 + kstep; const char* b3 = b2 + kstep;
            unsigned o2[2][2];
            if constexpr (GA) { if (last && has_next) { PG8_ROWS(nxtA, nxt); } else if (last) { _Pragma("unroll") for (int h = 0; h < 2; ++h) _Pragma("unroll") for (int i = 0; i < 2; ++i) nxtA[h][i] = curA[h][i]; } }
#pragma unroll
            for (int h = 0; h < 2; ++h)
#pragma unroll
                for (int i = 0; i < 2; ++i) o2[h][i] = (GA && last) ? nxtA[h][i] : curA[h][i];
            PG8_LDB(B0, 0, 0); PG8_LDB(B1, 0, 1); PG8_SCHED; PG8_LDA(At, 0, 0); PG8_STAGE(PG8_SA(1, 1), a1, curA[1]);
            PG8_WAIT_V(8); PG8_WAIT_L(0); PG8_BAR; PG8_MMA(0, 0, At, B0); PG8_MMA(0, 1, At, B1); PG8_BAR; PG8_SCHED;
            PG8_LDA(At, 0, 1); PG8_STAGE(PG8_SB(0, 0), b2, voffB); PG8_STAGE(PG8_SB(0, 1), b2 + hstep, voffB); PG8_STAGE(PG8_SA(0, 0), a2, o2[0]);
            PG8_WAIT_V(8); PG8_WAIT_L(0); PG8_BAR; PG8_MMA(1, 0, At, B0); PG8_MMA(1, 1, At, B1); PG8_BAR; PG8_SCHED;
            PG8_LDB(B0, 1, 0); PG8_LDB(B1, 1, 1); PG8_SCHED; PG8_LDA(At, 1, 0); PG8_STAGE(PG8_SA(0, 1), a2, o2[1]);
            PG8_WAIT_V(8); PG8_WAIT_L(0); PG8_BAR; PG8_MMA(0, 0, At, B0); PG8_MMA(0, 1, At, B1); PG8_BAR; PG8_SCHED;
            PG8_LDA(At, 1, 1); PG8_STAGE(PG8_SB(1, 0), b3, voffB); PG8_STAGE(PG8_SB(1, 1), b3 + hstep, voffB); PG8_STAGE(PG8_SA(1, 0), a3, o2[0]);
            PG8_WAIT_V(8); PG8_WAIT_L(0); PG8_BAR; PG8_MMA(1, 0, At, B0); PG8_MMA(1, 1, At, B1); PG8_BAR; PG8_SCHED;
        }
        if constexpr (ALIGN_EPI) { if (wr == 0) PG8_BAR; }
        E(acc, cur, wr, wc, fr, fq);
        if (!has_next) break;
#pragma unroll
        for (int a = 0; a < 2; ++a)
#pragma unroll
            for (int b = 0; b < 2; ++b)
#pragma unroll
                for (int m = 0; m < 4; ++m)
#pragma unroll
                    for (int n = 0; n < 2; ++n) acc[a][b][m][n] = (f32x4){0.f, 0.f, 0.f, 0.f};
        cur = nxt; cA = nA; cB = nB; ++ui;
        if constexpr (GA) {
#pragma unroll
            for (int h = 0; h < 2; ++h)
#pragma unroll
                for (int i = 0; i < 2; ++i) curA[h][i] = nxtA[h][i]; }
        if constexpr (ALIGN_EPI) { if (wr == 1) PG8_BAR; }
    }
    PG8_WAIT_V(0);
    if constexpr (!ALIGN_EPI) { if (wr == 0) PG8_BAR; }
    PG8_BAR;
#undef PG8_SA
#undef PG8_SB
#undef PG8_STAGE
#undef PG8_LDA
#undef PG8_LDB
#undef PG8_MMA
#undef PG8_WAIT_V
#undef PG8_WAIT_L
#undef PG8_BAR
#undef PG8_SCHED
#undef PG8_ROWS
}
}
#include <hip/hip_bf16.h>
#include <cmath>
namespace attn_body {
using bf16=__hip_bfloat16;
using bf16x8=__attribute__((ext_vector_type(8)))short;
using s16x4=__attribute__((ext_vector_type(4)))short;
using f32x16=__attribute__((ext_vector_type(16)))float;
using u32x4=__attribute__((ext_vector_type(4)))unsigned;
constexpr int D=64,QP=512,KP=128,OP=1024;
constexpr int NW=8,QBLK=32,QB=QBLK*NW,KVBLK=64;
constexpr int ATTN_UNIT_ROWS=QB;
__device__ __forceinline__ int crow(int r,int hi){return (r&3)+8*(r>>2)+4*hi;}
#define SBAR() __builtin_amdgcn_sched_barrier(0)

constexpr int NSLOT=3, SLOTB=8192;
constexpr int LDS_K=0, LDS_V=NSLOT*SLOTB, LDS_WS=2*NSLOT*SLOTB, LDS_OST=LDS_WS+NW*64*4, LDS_BYTES=LDS_OST+NW*4096;
constexpr float C2=0.125f*1.4426950408889634f;
__device__ __forceinline__ void glds16(const void*gsrc,unsigned lds_dst){unsigned keep;
  asm volatile("s_mov_b32 %0, m0\n\ts_mov_b32 m0, %2\n\ts_nop 0\n\tglobal_load_lds_dwordx4 %1, off\n\ts_mov_b32 m0, %0":"=&s"(keep):"v"(gsrc),"s"(lds_dst):"memory");}
__device__ __forceinline__ float max3f(float a,float b,float c){float r;asm("v_max3_f32 %0, %1, %2, %3":"=v"(r):"v"(a),"v"(b),"v"(c));return r;}
__device__ __forceinline__ float max2f(float a,float b){float r;asm("v_max_f32_e32 %0, %1, %2":"=v"(r):"v"(a),"v"(b));return r;}
__device__ __forceinline__ float fadd_s(float a,float b){float r;asm("v_add_f32_e32 %0, %1, %2":"=v"(r):"v"(a),"v"(b));return r;}
__device__ __forceinline__ float fsub_s(float a,float b){float r;asm("v_sub_f32_e32 %0, %1, %2":"=v"(r):"v"(a),"v"(b));return r;}
typedef float f32x2_t __attribute__((ext_vector_type(2))); typedef __bf16 bf16x2_t __attribute__((ext_vector_type(2)));
__device__ __forceinline__ unsigned cvtpk_s(float lo,float hi){f32x2_t v={lo,hi};bf16x2_t b=__builtin_convertvector(v,bf16x2_t);return __builtin_bit_cast(unsigned,b);}
#define WAIT_BAR(N) asm volatile("s_waitcnt vmcnt(" #N ") lgkmcnt(0)\n\ts_barrier":::"memory")

__device__ __forceinline__ void qkt(f32x16&p0,f32x16&p1,const char*Kslot,const bf16x8*qr,const f32x16&negm,int r32,int hi){
  const char*kb=Kslot+hi*1024+r32*16;
  #pragma unroll
  for(int d0=0;d0<4;++d0){
    const bf16x8 b0=*reinterpret_cast<const bf16x8*>(kb+d0*2048);
    const bf16x8 b1=*reinterpret_cast<const bf16x8*>(kb+d0*2048+512);
    if(d0==0){p0=__builtin_amdgcn_mfma_f32_32x32x16_bf16(b0,qr[0],negm,0,0,0);p1=__builtin_amdgcn_mfma_f32_32x32x16_bf16(b1,qr[0],negm,0,0,0);}
    else{p0=__builtin_amdgcn_mfma_f32_32x32x16_bf16(b0,qr[d0],p0,0,0,0);p1=__builtin_amdgcn_mfma_f32_32x32x16_bf16(b1,qr[d0],p1,0,0,0);}}
}
typedef __attribute__((address_space(3))) const char* lds_cptr;
typedef short v4i16_t __attribute__((ext_vector_type(4)));
__device__ __forceinline__ void kload8(bf16x8*kf,lds_cptr kp){
  kf[0]=*(const __attribute__((address_space(3))) bf16x8*)(kp);      kf[1]=*(const __attribute__((address_space(3))) bf16x8*)(kp+512);
  kf[2]=*(const __attribute__((address_space(3))) bf16x8*)(kp+2048); kf[3]=*(const __attribute__((address_space(3))) bf16x8*)(kp+2560);
  kf[4]=*(const __attribute__((address_space(3))) bf16x8*)(kp+4096); kf[5]=*(const __attribute__((address_space(3))) bf16x8*)(kp+4608);
  kf[6]=*(const __attribute__((address_space(3))) bf16x8*)(kp+6144); kf[7]=*(const __attribute__((address_space(3))) bf16x8*)(kp+6656);
}
__device__ __forceinline__ void kload2(bf16x8*kf,lds_cptr kp,int j){ kf[2*j]=*(const __attribute__((address_space(3))) bf16x8*)(kp+j*2048); kf[2*j+1]=*(const __attribute__((address_space(3))) bf16x8*)(kp+j*2048+512); }
__device__ __forceinline__ s16x4 vtr(lds_cptr p){ return __builtin_bit_cast(s16x4,__builtin_amdgcn_ds_read_tr16_b64_v4i16((__attribute__((address_space(3))) v4i16_t*)p)); }
__device__ __forceinline__ float rowmax(const f32x16&p0,const f32x16&p1){
  float a=max3f(p0[0],p0[1],p1[0]),b=max3f(p0[2],p0[3],p1[1]);a=max3f(a,p1[2],p1[3]);
  #pragma unroll
  for(int r=4;r<16;r+=4){a=max3f(a,p0[r],p0[r+1]);b=max3f(b,p0[r+2],p0[r+3]);a=max3f(a,p1[r],p1[r+1]);b=max3f(b,p1[r+2],p1[r+3]);}
  const float m=max2f(a,b);
  auto rr=__builtin_amdgcn_permlane32_swap(__float_as_uint(m),__float_as_uint(m),false,false);
  return max2f(__uint_as_float(rr[0]),__uint_as_float(rr[1]));
}
__device__ __forceinline__ void pv(f32x16*o,int vb,bf16x8 pa0,bf16x8 pa1,bf16x8 pa2,bf16x8 pa3){
  #pragma unroll
  for(int d0=0;d0<2;++d0){s16x4 lo[4],hi[4];
    #pragma unroll
    for(int ks=0;ks<4;++ks){
      asm volatile("ds_read_b64_tr_b16 %0,%1 offset:%c2":"=&v"(lo[ks]):"v"(vb),"i"(d0*4096+ks*1024):"memory");
      asm volatile("ds_read_b64_tr_b16 %0,%1 offset:%c2":"=&v"(hi[ks]):"v"(vb),"i"(d0*4096+ks*1024+512):"memory");}
    asm volatile("s_waitcnt lgkmcnt(0)":::"memory");SBAR();
    #define PK(k) (bf16x8){lo[k][0],lo[k][1],lo[k][2],lo[k][3],hi[k][0],hi[k][1],hi[k][2],hi[k][3]}
    o[d0]=__builtin_amdgcn_mfma_f32_32x32x16_bf16(pa0,PK(0),o[d0],0,0,0);
    o[d0]=__builtin_amdgcn_mfma_f32_32x32x16_bf16(pa1,PK(1),o[d0],0,0,0);
    o[d0]=__builtin_amdgcn_mfma_f32_32x32x16_bf16(pa2,PK(2),o[d0],0,0,0);
    o[d0]=__builtin_amdgcn_mfma_f32_32x32x16_bf16(pa3,PK(3),o[d0],0,0,0);
    #undef PK
  }
}

#ifndef ATTN_STORE16
#define ATTN_STORE16(p,v) (*(u32x4*)(p)=(v))
#endif
template<int THRL> __device__ __forceinline__ void attn_unit(const bf16*Qu,const bf16*__restrict__ Kh,const bf16*__restrict__ Vh,bf16*Ou,const int NT,char*shm){
  int tid_=threadIdx.x; asm volatile("":"+v"(tid_)); const int tid=tid_,lane=tid&63,r32=lane&31,hi=lane>>5; const int wid=__builtin_amdgcn_readfirstlane(tid>>6);
  const bf16*Qw=Qu+(long)(wid*QBLK)*QP;
  const unsigned lds0=(unsigned)(uintptr_t)shm;
  float*wsf=(float*)(shm+LDS_WS)+wid*64;
  const bf16*ksrc=Kh+(long)lane*KP+wid*8;
  const bf16*vsrc=Vh+(long)(16*(wid&3)+(lane>>2))*KP+(wid>>2)*32+(lane&3)*8;
  const unsigned kdst=lds0+LDS_K+wid*1024, vdst=lds0+LDS_V+wid*1024;
  #define DMA_K(t,slot) glds16(ksrc+(long)(t)*KVBLK*KP,(unsigned)__builtin_amdgcn_readfirstlane(kdst+(slot)))
  #define DMA_V(t,slot) glds16(vsrc+(long)(t)*KVBLK*KP,(unsigned)__builtin_amdgcn_readfirstlane(vdst+(slot)))
  const int vb0=(int)(lds0+LDS_V)+((lane>>4)&1)*32+(lane&3)*8+(4*hi+((lane&15)>>2))*64;
  const char*Kbase=shm+LDS_K; bf16x8 kf[8];
  const lds_cptr shm3=(lds_cptr)shm; const lds_cptr kp0=shm3+LDS_K+hi*1024+r32*16; const lds_cptr vp0=shm3+LDS_V+((lane>>4)&1)*32+(lane&3)*8+(4*hi+((lane&15)>>2))*64;
  DMA_K(0,0);DMA_V(0,0);DMA_K(1,SLOTB);
  bf16x8 qr[4];
  #pragma unroll
  for(int d0=0;d0<4;++d0)qr[d0]=*reinterpret_cast<const bf16x8*>(&Qw[(long)r32*QP+d0*16+hi*8]);
  float mhat=0.f,l_reg=0.f;f32x16 o[2];o[0]=f32x16{};o[1]=f32x16{};f32x16 negm=f32x16{};asm volatile("":"+v"(negm));
  #define CMASK(P0,P1,t) do{}while(0)
  bool resc=false;
  #define START(P0,P1) do{ const float rm=rowmax(P0,P1); resc=false; \
    { const float dl=rm; mhat=fadd_s(mhat,dl); \
      _Pragma("unroll") for(int r=0;r<16;++r){P0[r]=fsub_s(P0[r],dl);P1[r]=fsub_s(P1[r],dl);} \
      _Pragma("unroll") for(int r=0;r<16;++r)negm[r]=-mhat; asm volatile("":"+v"(negm)); } \
    _Pragma("unroll") for(int r=0;r<16;++r)P0[r]=__builtin_amdgcn_exp2f(P0[r]); }while(0)
  #define RESC() do{ if(resc){ asm volatile("s_waitcnt lgkmcnt(0)":::"memory"); \
      _Pragma("unroll") for(int d_=0;d_<2;++d_) _Pragma("unroll") for(int r=0;r<16;++r)o[d_][r]*=wsf[crow(r,hi)]; } }while(0)
  f32x16 pA0,pA1,pB0,pB1;
  int sl_prev=0,sl_cur=0,sl_next=SLOTB;
  #define ROT() do{sl_prev=sl_cur;sl_cur=sl_next;sl_next=(sl_next==(NSLOT-1)*SLOTB)?0:sl_next+SLOTB;}while(0)
  DMA_K(2,2*SLOTB);
  WAIT_BAR(3);
  qkt(pA0,pA1,Kbase,qr,negm,r32,hi);asm volatile("s_nop 15\n\ts_nop 7":"+v"(pA0),"+v"(pA1));CMASK(pA0,pA1,0);
  START(pA0,pA1);
  _Pragma("unroll") for(int r=0;r<16;++r)pA1[r]=__builtin_amdgcn_exp2f(pA1[r]);
  WAIT_BAR(0);
  DMA_K(3,0);DMA_V(1,SLOTB);
  ROT();
  kload8(kf,kp0+sl_cur);
  WAIT_BAR(2);
  s16x4 vlo[8],vhi[8]; u32x4 pw0,pw1,pw2,pw3;
  #define PKW(P,B) cvtpk_s(P[B],P[B+1])
  #define PAF(k) __builtin_bit_cast(bf16x8,pw##k)
  #define VFR(i) (bf16x8){vlo[i][0],vlo[i][1],vlo[i][2],vlo[i][3],vhi[i][0],vhi[i][1],vhi[i][2],vhi[i][3]}
  #define PIN(x) asm volatile("":"+v"(x))
  #define MX3(a,b,c) __builtin_fmaxf(__builtin_fmaxf((a),(b)),(c))
  #define GAPA(MF,A0,A1,A2,A3,W0,W1,PW) do{ MF; sacc+=A0; sacc+=A1; sacc+=A2; sacc+=A3; PIN(sacc); W0; W1; PIN(PW); SBAR(); }while(0)
  #define EX(v) __builtin_amdgcn_exp2f(v)
  #define GAPB(MF,X,B) do{ MF; X[B]=EX(X[B]); X[B+1]=EX(X[B+1]); X[B+2]=EX(X[B+2]); X[B+3]=EX(X[B+3]); PIN(X); SBAR(); }while(0)
  #define VRD(i) do{ vlo[i]=vtr(vp_+(((i)>>2)*4096+((i)&3)*1024)); vhi[i]=vtr(vp_+(((i)>>2)*4096+((i)&3)*1024+512)); }while(0)
  #define KRD(G,j) do{ if(G){ kload2(kf,kp0+sl_next,j); SBAR(); } }while(0)
  #define STEP(C0,C1,P0,P1,t,GK,GV,GL) do{ SBAR(); \
    const lds_cptr vp_=vp0+sl_prev; \
    VRD(0); SBAR(); float sacc=(P0[0]+P0[1]); \
    GAPA(C0=__builtin_amdgcn_mfma_f32_32x32x16_bf16(kf[0],qr[0],negm,0,0,0), P0[2],P0[3],P0[4],P0[5],     pw0[0]=PKW(P0,0), pw0[1]=PKW(P0,2), pw0); \
    VRD(4); SBAR(); GAPA(C1=__builtin_amdgcn_mfma_f32_32x32x16_bf16(kf[1],qr[0],negm,0,0,0), P0[6],P0[7],P0[8],P0[9],     pw0[2]=PKW(P0,4), pw0[3]=PKW(P0,6), pw0); \
    VRD(1); SBAR(); GAPA(C0=__builtin_amdgcn_mfma_f32_32x32x16_bf16(kf[2],qr[1],C0,0,0,0),   P0[10],P0[11],P0[12],P0[13], pw1[0]=PKW(P0,8), pw1[1]=PKW(P0,10), pw1); \
    VRD(5); SBAR(); GAPA(C1=__builtin_amdgcn_mfma_f32_32x32x16_bf16(kf[3],qr[1],C1,0,0,0),   P0[14],P0[15],P1[0],P1[1],   pw1[2]=PKW(P0,12),pw1[3]=PKW(P0,14), pw1); \
    VRD(2); SBAR(); GAPA(C0=__builtin_amdgcn_mfma_f32_32x32x16_bf16(kf[4],qr[2],C0,0,0,0),   P1[2],P1[3],P1[4],P1[5],     pw2[0]=PKW(P1,0), pw2[1]=PKW(P1,2), pw2); \
    VRD(6); SBAR(); GAPA(C1=__builtin_amdgcn_mfma_f32_32x32x16_bf16(kf[5],qr[2],C1,0,0,0),   P1[6],P1[7],P1[8],P1[9],     pw2[2]=PKW(P1,4), pw2[3]=PKW(P1,6), pw2); \
    VRD(3); SBAR(); GAPA(C0=__builtin_amdgcn_mfma_f32_32x32x16_bf16(kf[6],qr[3],C0,0,0,0),   P1[10],P1[11],P1[12],P1[13], pw3[0]=PKW(P1,8), pw3[1]=PKW(P1,10), pw3); \
    VRD(7); SBAR(); GAPA(C1=__builtin_amdgcn_mfma_f32_32x32x16_bf16(kf[7],qr[3],C1,0,0,0),   P1[14],P1[15],0.f,0.f,       pw3[2]=PKW(P1,12),pw3[3]=PKW(P1,14), pw3); \
    l_reg+=sacc; \
    if(GK){DMA_K((t)+3,sl_cur);} if(GV){DMA_V((t)+1,sl_next);} \
    CMASK(C0,C1,t); \
    { float a=MX3(C0[0],C0[1],C1[0]),b=MX3(C0[2],C0[3],C1[1]); a=MX3(a,C1[2],C1[3]); \
      _Pragma("unroll") for(int r=4;r<16;r+=4){a=MX3(a,C0[r],C0[r+1]);b=MX3(b,C0[r+2],C0[r+3]);a=MX3(a,C1[r],C1[r+1]);b=MX3(b,C1[r+2],C1[r+3]);} \
      float rm=__builtin_fmaxf(a,b); { auto rr=__builtin_amdgcn_permlane32_swap(__float_as_uint(rm),__float_as_uint(rm),false,false); rm=__builtin_fmaxf(__uint_as_float(rr[0]),__uint_as_float(rr[1])); } \
      resc=false; \
      if(__builtin_expect(__any(rm>(float)THRL),0)){ const float dl=__builtin_fmaxf(rm,0.f); mhat+=dl; \
        _Pragma("unroll") for(int r=0;r<16;++r){C0[r]-=dl;C1[r]-=dl;} \
        _Pragma("unroll") for(int r=0;r<16;++r)negm[r]=-mhat; asm volatile("":"+v"(negm)); \
        const float f=__builtin_amdgcn_exp2f(-dl); l_reg*=f; if(hi==0)wsf[r32]=f; resc=true; } } \
    SBAR(); \
    GAPB(o[0]=__builtin_amdgcn_mfma_f32_32x32x16_bf16(PAF(0),VFR(0),o[0],0,0,0), C0,0); \
    GAPB(o[1]=__builtin_amdgcn_mfma_f32_32x32x16_bf16(PAF(0),VFR(4),o[1],0,0,0), C0,4); \
    KRD(GL,0); GAPB(o[0]=__builtin_amdgcn_mfma_f32_32x32x16_bf16(PAF(1),VFR(1),o[0],0,0,0), C0,8); \
    KRD(GL,1); GAPB(o[1]=__builtin_amdgcn_mfma_f32_32x32x16_bf16(PAF(1),VFR(5),o[1],0,0,0), C0,12); \
    KRD(GL,2); GAPB(o[0]=__builtin_amdgcn_mfma_f32_32x32x16_bf16(PAF(2),VFR(2),o[0],0,0,0), C1,0); \
    KRD(GL,3); GAPB(o[1]=__builtin_amdgcn_mfma_f32_32x32x16_bf16(PAF(2),VFR(6),o[1],0,0,0), C1,4); \
    GAPB(o[0]=__builtin_amdgcn_mfma_f32_32x32x16_bf16(PAF(3),VFR(3),o[0],0,0,0), C1,8); \
    GAPB(o[1]=__builtin_amdgcn_mfma_f32_32x32x16_bf16(PAF(3),VFR(7),o[1],0,0,0), C1,12); \
    }while(0)
  int t=1;
  #undef CMASK
  #define CMASK(P0,P1,t) do{}while(0)
  for(;t+5<NT;t+=2){
    STEP(pB0,pB1,pA0,pA1,t,true,true,true);     WAIT_BAR(2); RESC(); ROT();
    STEP(pA0,pA1,pB0,pB1,t+1,true,true,true);   WAIT_BAR(2); RESC(); ROT();
  }
  #undef CMASK
  #define CMASK(P0,P1,t) do{}while(0)
  #define ENDW(tt) do{ if((tt)+3<NT){WAIT_BAR(2);} else if((tt)+2<NT){WAIT_BAR(1);} else {WAIT_BAR(0);} }while(0)
  for(;t+1<NT;t+=2){
    STEP(pB0,pB1,pA0,pA1,t,(t+3<NT),(t+1<NT),(t+1<NT));       ENDW(t);   RESC(); ROT();
    STEP(pA0,pA1,pB0,pB1,t+1,(t+4<NT),(t+2<NT),(t+2<NT));     ENDW(t+1); RESC(); ROT();
  }
  STEP(pB0,pB1,pA0,pA1,NT-1,false,false,false); RESC();
  { float sacc=pB0[0]+pB0[1]; _Pragma("unroll") for(int r=2;r<16;++r)sacc+=pB0[r]; _Pragma("unroll") for(int r=0;r<16;++r)sacc+=pB1[r]; l_reg+=sacc;
    pw0=(u32x4){PKW(pB0,0),PKW(pB0,2),PKW(pB0,4),PKW(pB0,6)};pw1=(u32x4){PKW(pB0,8),PKW(pB0,10),PKW(pB0,12),PKW(pB0,14)};pw2=(u32x4){PKW(pB1,0),PKW(pB1,2),PKW(pB1,4),PKW(pB1,6)};pw3=(u32x4){PKW(pB1,8),PKW(pB1,10),PKW(pB1,12),PKW(pB1,14)};
    SBAR(); pv(o,vb0+sl_cur,PAF(0),PAF(1),PAF(2),PAF(3)); }
  #undef PKW
  #undef PAF
  #undef VFR
  #undef PIN
  #undef MX3
  #undef GAPA
  #undef GAPB
  #undef EX
  #undef VRD
  #undef KRD
  #undef STEP
  #undef ENDW
  {auto rr=__builtin_amdgcn_permlane32_swap(__float_as_uint(l_reg),__float_as_uint(l_reg),false,false);l_reg=__uint_as_float(rr[0])+__uint_as_float(rr[1]);}
  if(hi==0)wsf[32+r32]=l_reg;asm volatile("s_waitcnt lgkmcnt(0)":::"memory");
  float rli[16];
  #pragma unroll
  for(int r=0;r<16;++r)rli[r]=__builtin_amdgcn_rcpf(wsf[32+crow(r,hi)]);
  bf16*Ow=Ou+(long)(wid*QBLK)*OP;
  { bf16*stg=(bf16*)(shm+LDS_OST)+wid*2048;
    #pragma unroll
    for(int r=0;r<16;++r){const int orow=crow(r,hi);
      #pragma unroll
      for(int d0=0;d0<2;++d0)stg[orow*64+d0*32+r32]=__float2bfloat16(o[d0][r]*rli[r]);}
    asm volatile("s_waitcnt lgkmcnt(0)":::"memory");
    #pragma unroll
    for(int i=0;i<4;++i){const int row=i*8+(lane>>3),ch=lane&7; const u32x4 v=*(const u32x4*)(stg+row*64+ch*8); ATTN_STORE16(Ow+(long)row*OP+ch*8,v);} }
  asm volatile("s_waitcnt lgkmcnt(0)\n\ts_barrier":::"memory");
  #undef DMA_K
  #undef DMA_V
  #undef CMASK
  #undef START
  #undef RESC
  #undef ROT
}
constexpr int ATTN_LDS_BYTES=LDS_BYTES;
#undef SBAR
#undef WAIT_BAR
}


constexpr int NWAVES = 8;
constexpr int D = 1024, NBATCH = 8, SEQ = 4096, DEPTH = 4, CTXL = 256;
constexpr int TLAT = NBATCH * SEQ, TCTX = NBATCH * CTXL, TTOK = TLAT + TCTX;
constexpr int INW = 1536, OFF_POOL = 0, OFF_U = 256, OFF_V = 512, OFF_Q = 768, OFF_K = 1280, OFF_VAL = 1408;
constexpr int NEXP = 16, CAP_L = 512, CAP_C = 32, EROWS = NBATCH * CAP_L + NBATCH * CAP_C;
constexpr int KVROWS = SEQ + CTXL;
constexpr float LN_EPS = 1e-6f;
constexpr float DN_ALPHA = 1.681792830507429f;
constexpr int MODW = 6 * D;
constexpr int NCOND = 9;

constexpr size_t MiB = 1u << 20;
constexpr size_t WS_CTL = 0, CTL_ZERO_BYTES = 1 * MiB;
constexpr size_t WS_MOD = 1 * MiB;
constexpr size_t WS_AFF = 2 * MiB;
constexpr size_t WS_INV = 5 * MiB;
constexpr size_t WS_ROWIDX = 8 * MiB;
constexpr size_t WS_GATE = 8 * MiB + 512 * 1024;
constexpr size_t WS_COS = 9 * MiB, WS_SIN = 9 * MiB + 512 * 1024;
constexpr size_t WS_SGUW = 10 * MiB;
constexpr size_t WS_PWT = 10 * MiB + 512 * 1024;
constexpr size_t WS_WIN = 12 * MiB;
constexpr size_t WS_WOUT = 24 * MiB;
constexpr size_t WS_W13 = 32 * MiB;
constexpr size_t WS_W2 = 288 * MiB;
constexpr size_t WS_X = 416 * MiB;
constexpr size_t WS_H = 552 * MiB;
constexpr size_t WS_Z = 620 * MiB;
constexpr size_t WS_Q = 722 * MiB;
constexpr size_t WS_HID = 620 * MiB;
constexpr size_t WS_MIX = 756 * MiB;
constexpr size_t WS_Y = 824 * MiB;
constexpr size_t WS_YEXP = 756 * MiB;
constexpr size_t WS_K = 892 * MiB, WS_V = 901 * MiB;
constexpr size_t WS_END = 910 * MiB;
constexpr int CW_BAR = 4096;

constexpr int RING_OFF = 0, RING_BYTES = 131072;
constexpr int LDSCTL_OFF = RING_BYTES, MISC_OFF = LDSCTL_OFF + 320;
constexpr int LDS_BYTES = 147456;

#define GAS __attribute__((address_space(1)))
#define LAS __attribute__((address_space(3)))
typedef unsigned short bf16;
typedef unsigned v4u __attribute__((ext_vector_type(4)));
typedef unsigned v2u __attribute__((ext_vector_type(2)));
typedef float f32x4 __attribute__((ext_vector_type(4)));
typedef float f32x2 __attribute__((ext_vector_type(2)));
typedef short bf16x8 __attribute__((ext_vector_type(8)));
#define LDS_WAIT() asm volatile("s_waitcnt lgkmcnt(0)" ::: "memory")
__device__ __forceinline__ unsigned f2bf(float f) { unsigned u = __builtin_bit_cast(unsigned, f); return (u + 0x7fffu + ((u >> 16) & 1u)) >> 16; }
__device__ __forceinline__ unsigned pk2(float lo, float hi) { return f2bf(lo) | (f2bf(hi) << 16); }
__device__ __forceinline__ float bflo(unsigned w) { return __builtin_bit_cast(float, w << 16); }
__device__ __forceinline__ float bfhi(unsigned w) { return __builtin_bit_cast(float, w & 0xffff0000u); }
__device__ __forceinline__ float bf1(bf16 b) { return __builtin_bit_cast(float, ((unsigned)b) << 16); }
__device__ __forceinline__ float gelu_tanh(float x) {
    const float u = 0.7978845608028654f * (x + 0.044715f * x * x * x);
    return x * __builtin_amdgcn_rcpf(1.0f + __builtin_amdgcn_exp2f(-2.8853900817779268f * u));
}

#define XB_TMO      128
#define XB_XCNT(j)  (256  + 64 * (j))
#define XB_XSUB(j)  (1280 + 64 * (j))
#define XB_XGEN(j)  (2304 + 64 * (j))
#define XB_TOP      3328
#define XB_TOPGEN   3392
#define XCD_BAR_WORDS 3456
#define XB_SPIN_CAP (1u << 18)

__device__ __forceinline__ unsigned xb_ld(unsigned* p)              { return __hip_atomic_load(p, __ATOMIC_RELAXED, __HIP_MEMORY_SCOPE_AGENT); }
__device__ __forceinline__ unsigned xb_add(unsigned* p, unsigned v) { return __hip_atomic_fetch_add(p, v, __ATOMIC_RELAXED, __HIP_MEMORY_SCOPE_AGENT); }
__device__ __forceinline__ unsigned xb_xcc_id() { return (unsigned)__builtin_amdgcn_s_getreg((3 << 11) | 20) & 0xFu; }
#define XB_SPIN(cond, bar) do { unsigned _sp = 0; while (cond) { __builtin_amdgcn_s_sleep(1); \
    if ((++_sp & 255u) == 0u) { if (xb_ld(&(bar)[XB_TMO])) break; if (_sp > XB_SPIN_CAP) { atomicAdd(&(bar)[XB_TMO], 1u); break; } } } } while (0)

struct XcdBarrier {
    unsigned* bar; unsigned x;
    volatile LAS unsigned* st;
};
__device__ __forceinline__ XcdBarrier xcd_barrier_post(unsigned* bar, volatile LAS unsigned* st) {
    XcdBarrier b; b.bar = bar; b.x = xb_xcc_id(); b.st = st;
    if (threadIdx.x == 0) (void)xb_add(&bar[XB_XCNT(b.x)], 1u);
    return b;
}
__device__ __forceinline__ void xcd_barrier_complete(unsigned* bar, unsigned x, unsigned& nloc, unsigned& nx) {
    const unsigned G = gridDim.x * gridDim.y * gridDim.z;
    unsigned sum, cnt, mine, sp = 0u;
    for (;;) {
        sum = 0u; cnt = 0u; mine = 0u;
#pragma unroll
        for (unsigned j = 0; j < 16; ++j) { const unsigned c = xb_ld(&bar[XB_XCNT(j)]); sum += c; cnt += (c > 0u) ? 1u : 0u; mine = (j == x) ? c : mine; }
        if (sum == G) break;
        __builtin_amdgcn_s_sleep(1);
        if ((++sp & 255u) == 0u) { if (xb_ld(&bar[XB_TMO])) break; if (sp > XB_SPIN_CAP) { atomicAdd(&bar[XB_TMO], 1u); break; } }
    }
    nloc = mine > 0u ? mine : 1u; nx = cnt > 0u ? cnt : 1u;
}
__device__ __forceinline__ void xcd_barrier(const XcdBarrier& b) {
    asm volatile("s_waitcnt vmcnt(0)" ::: "memory");
    __syncthreads();
    if (threadIdx.x == 0) {
        unsigned* bar = b.bar;
        __builtin_amdgcn_s_waitcnt(0);
        unsigned nloc = b.st[0], nx = b.st[1];
        if (nloc == 0u) { xcd_barrier_complete(bar, b.x, nloc, nx); b.st[0] = nloc; b.st[1] = nx; }
        const unsigned old = xb_add(&bar[XB_XSUB(b.x)], 1u);
        const unsigned gen = old / nloc;
        if (old + 1u == (gen + 1u) * nloc) {
            __builtin_amdgcn_fence(__ATOMIC_RELEASE, "agent");
            asm volatile("s_waitcnt vmcnt(0)" ::: "memory");
            const unsigned og = xb_add(&bar[XB_TOP], 1u);
            const unsigned tg = og / nx;
            if (og + 1u == (tg + 1u) * nx) xb_add(&bar[XB_TOPGEN], 1u);
            else XB_SPIN(xb_ld(&bar[XB_TOPGEN]) == tg, bar);
            __builtin_amdgcn_fence(__ATOMIC_ACQUIRE, "agent");
            xb_add(&bar[XB_XGEN(b.x)], 1u);
            asm volatile("s_waitcnt vmcnt(0)" ::: "memory");
        } else {
            XB_SPIN(xb_ld(&bar[XB_XGEN(b.x)]) == gen, bar);
            __builtin_amdgcn_fence(__ATOMIC_ACQUIRE, "agent");
            asm volatile("s_waitcnt vmcnt(0)" ::: "memory");
        }
    }
    __syncthreads();
}

struct Args { const float* in[23]; float* out; unsigned char* ws; int ph_lo, ph_hi; };
struct Frame {
    LAS unsigned char* lds;
    int tid, lane, wave, vcu, G;
    const float* const* in;
    float* out; unsigned char* ws;
};
__device__ __forceinline__ void frame_ids(Frame& F) { int t = threadIdx.x; asm volatile("" : "+v"(t)); F.tid = t; F.lane = t & 63; F.wave = __builtin_amdgcn_readfirstlane(t >> 6); }
template <int CTRL> __device__ __forceinline__ float dppmov(float v) { return __uint_as_float((unsigned)__builtin_amdgcn_update_dpp(0, (int)__float_as_uint(v), CTRL, 0xf, 0xf, true)); }
__device__ __forceinline__ float xsum16(float v) { auto r = __builtin_amdgcn_permlane16_swap(__float_as_uint(v), __float_as_uint(v), false, false); return __uint_as_float(r[0]) + __uint_as_float(r[1]); }
__device__ __forceinline__ float xsum32(float v) { auto r = __builtin_amdgcn_permlane32_swap(__float_as_uint(v), __float_as_uint(v), false, false); return __uint_as_float(r[0]) + __uint_as_float(r[1]); }
__device__ __forceinline__ float xmax16(float v) { auto r = __builtin_amdgcn_permlane16_swap(__float_as_uint(v), __float_as_uint(v), false, false); return fmaxf(__uint_as_float(r[0]), __uint_as_float(r[1])); }
__device__ __forceinline__ float xmax32(float v) { auto r = __builtin_amdgcn_permlane32_swap(__float_as_uint(v), __float_as_uint(v), false, false); return fmaxf(__uint_as_float(r[0]), __uint_as_float(r[1])); }
__device__ __forceinline__ float wave_sum(float v) {
    v += dppmov<0xB1>(v); v += dppmov<0x4E>(v); v += dppmov<0x141>(v); v += dppmov<0x140>(v);
    return xsum32(xsum16(v));
}
__device__ __forceinline__ void row_ln(f32x4 (&v)[4]) {
    float s = 0.f;
#pragma unroll
    for (int j = 0; j < 4; ++j) s += (v[j].x + v[j].y) + (v[j].z + v[j].w);
    const float mean = wave_sum(s) * (1.f / D); float s2 = 0.f;
#pragma unroll
    for (int j = 0; j < 4; ++j) { v[j] = v[j] - mean; s2 += (v[j].x * v[j].x + v[j].y * v[j].y) + (v[j].z * v[j].z + v[j].w * v[j].w); }
    const float rstd = 1.f / sqrtf(wave_sum(s2) * (1.f / D) + LN_EPS);
#pragma unroll
    for (int j = 0; j < 4; ++j) v[j] = v[j] * rstd;
}
__device__ __forceinline__ void row_load(f32x4 (&v)[4], const float* p, int lane) {
    const GAS f32x4* r = (const GAS f32x4*)p + lane;
#pragma unroll
    for (int j = 0; j < 4; ++j) v[j] = r[64 * j];
}
__device__ __forceinline__ void row_store(const f32x4 (&v)[4], float* p, int lane) {
    GAS f32x4* r = (GAS f32x4*)p + lane;
#pragma unroll
    for (int j = 0; j < 4; ++j) r[64 * j] = v[j];
}
__device__ __forceinline__ void row_store_bf16(const f32x4 (&v)[4], bf16* p, int lane) {
    GAS v2u* o = (GAS v2u*)p + lane;
#pragma unroll
    for (int j = 0; j < 4; ++j) { v2u w; w.x = pk2(v[j].x, v[j].y); w.y = pk2(v[j].z, v[j].w); o[64 * j] = w; }
}
__device__ __forceinline__ void row_load_bf16(f32x4 (&v)[4], const bf16* p, int lane) {
    const GAS v2u* r = (const GAS v2u*)p + lane;
#pragma unroll
    for (int j = 0; j < 4; ++j) { const v2u w = r[64 * j]; v[j] = (f32x4){bflo(w.x), bfhi(w.x), bflo(w.y), bfhi(w.y)}; }
}
__device__ __forceinline__ int tok_cond(int tok) { return tok < TLAT ? (tok >> 12) : NBATCH; }
__device__ __forceinline__ const float* x_input_row(const Frame& F, int tok) { return tok < TLAT ? F.in[0] + (size_t)tok * D : F.in[2] + (size_t)(tok - TLAT) * D; }

__device__ const double ROPE_INV[16] = {1.0, 0.5623413251903491, 0.31622776601683794, 0.1778279410038923, 0.1, 0.05623413251903491, 0.03162277660168379, 0.01778279410038923,
    0.01, 0.005623413251903491, 0.0031622776601683794, 0.0017782794100389228, 0.001, 0.0005623413251903491, 0.00031622776601683794, 0.00017782794100389227};
__device__ __forceinline__ void sincos_small(double a, double& s, double& c) {
    const double k = rint(a * 0.15915494309189535);
    double r = fma(-k, 6.283185307179586, a); r = fma(-k, 2.4492935982947064e-16, r);
    const double x = r * 0.125, x2 = x * x;
    double sn = x * (1.0 + x2 * (-1.0 / 6 + x2 * (1.0 / 120 + x2 * (-1.0 / 5040 + x2 * (1.0 / 362880 + x2 * (-1.0 / 39916800))))));
    double cs = 1.0 + x2 * (-0.5 + x2 * (1.0 / 24 + x2 * (-1.0 / 720 + x2 * (1.0 / 40320 + x2 * (-1.0 / 3628800 + x2 * (1.0 / 479001600))))));
#pragma unroll
    for (int i = 0; i < 3; ++i) { const double s2 = 2.0 * sn * cs, c2 = 1.0 - 2.0 * sn * sn; sn = s2; cs = c2; }
    s = sn; c = cs;
}
__device__ __forceinline__ void p0_transpose_item(const float* W, int K, int N, bf16* WT, int kb, int nb, int drow0, LAS float* scr, int lane) {
    const int k0 = 64 * kb, n0 = 32 * nb;
#pragma unroll 8
    for (int i = 0; i < 32; ++i) { const int kk = 2 * i + (lane >> 5); scr[kk * 33 + (lane & 31)] = W[(size_t)(k0 + kk) * N + n0 + (lane & 31)]; }
    LDS_WAIT(); asm volatile("" ::: "memory");
    const int c = lane & 7;
#pragma unroll
    for (int j = 0; j < 4; ++j) { const int n = (lane >> 3) + 8 * j; const LAS float* s = scr + (8 * c) * 33 + n;
        v4u o; o.x = pk2(s[0 * 33], s[1 * 33]); o.y = pk2(s[2 * 33], s[3 * 33]); o.z = pk2(s[4 * 33], s[5 * 33]); o.w = pk2(s[6 * 33], s[7 * 33]);
        *(GAS v4u*)(WT + (size_t)(drow0 + n) * K + k0 + 8 * c) = o; }
    LDS_WAIT(); asm volatile("" ::: "memory");
}
__device__ __forceinline__ void p0_prologue(Frame& F) {
    frame_ids(F);
    const float* c_in = F.in[1]; const float* cctx_in = F.in[3]; const float* w_mod = F.in[4]; const float* b_mod = F.in[5];
    float* MOD = (float*)(F.ws + WS_MOD);
    const int bx = blockIdx.x;
    for (int it = bx; it < DEPTH * 48; it += F.G) {
        LAS float* scond = (LAS float*)(F.lds);
        LAS float* red = (LAS float*)(F.lds + 36864);
        for (int i = F.tid; i < NCOND * D; i += NWAVES * 64) { const int n = i >> 10, k = i & 1023; const float cv = n < NBATCH ? c_in[n * D + k] : cctx_in[k];
            scond[i] = cv / (1.0f + expf(-cv)); }
        __syncthreads();
        const int l = it / 48, cb = it % 48;
        const float* wp = w_mod + ((size_t)l * D + F.wave * 128) * MODW + cb * 128 + 2 * F.lane;
        float acc[NCOND][2];
#pragma unroll
        for (int n = 0; n < NCOND; ++n) { acc[n][0] = 0.f; acc[n][1] = 0.f; }
#pragma unroll 8
        for (int kk = 0; kk < 128; ++kk) { const f32x2 wv = *(const GAS f32x2*)(wp + (size_t)kk * MODW);
#pragma unroll
            for (int n = 0; n < NCOND; ++n) { const float s = scond[n * D + F.wave * 128 + kk]; acc[n][0] += s * wv.x; acc[n][1] += s * wv.y; } }
#pragma unroll
        for (int n = 0; n < NCOND; ++n) { red[(F.wave * NCOND + n) * 128 + 2 * F.lane] = acc[n][0]; red[(F.wave * NCOND + n) * 128 + 2 * F.lane + 1] = acc[n][1]; }
        __syncthreads();
        for (int o = F.tid; o < NCOND * 128; o += NWAVES * 64) { const int n = o >> 7, cc = o & 127; float s = 0.f;
#pragma unroll
            for (int w = 0; w < NWAVES; ++w) s += red[(w * NCOND + n) * 128 + cc];
            MOD[((size_t)l * NCOND + n) * MODW + cb * 128 + cc] = s + b_mod[l * MODW + cb * 128 + cc]; }
        __syncthreads();
    }
    { float* COS = (float*)(F.ws + WS_COS); float* SIN = (float*)(F.ws + WS_SIN);
      for (int gt = bx * (NWAVES * 64) + F.tid; gt < SEQ * 32; gt += F.G * NWAVES * 64) { const int pos = gt >> 5, i = gt & 31; const int p = (i < 16) ? (pos >> 6) : (pos & 63);
          double s, c; sincos_small((double)p * ROPE_INV[i & 15], s, c); COS[gt] = (float)c; SIN[gt] = (float)s; } }
    { const float* sgu_w = F.in[10]; const float* pool_w = F.in[7]; bf16* SGUW = (bf16*)(F.ws + WS_SGUW); bf16* PWT = (bf16*)(F.ws + WS_PWT);
      for (int i = bx * (NWAVES * 64) + F.tid; i < DEPTH * 4 * 128 * 128; i += F.G * NWAVES * 64) SGUW[i] = (bf16)f2bf(sgu_w[i]);
      for (int i = bx * (NWAVES * 64) + F.tid; i < DEPTH * 4 * 64 * 64; i += F.G * NWAVES * 64) { const int lg = i >> 12, j = (i >> 6) & 63, ii = i & 63; PWT[i] = (bf16)f2bf(pool_w[(lg << 12) + ii * 64 + j]); } }
    LAS float* scr = (LAS float*)(F.lds + RING_OFF + F.wave * 16384);
    const int gw = F.vcu * NWAVES + F.wave, NGW = F.G * NWAVES;
    constexpr int I_IN = 16 * 48, I_OUT = 16 * 32, I_SQ = 16 * 32;
    constexpr int N_DENSE = DEPTH * (I_IN + I_OUT), N_MOE = DEPTH * NEXP * 3 * I_SQ;
    for (int it = gw; it < N_DENSE + N_MOE; it += NGW) {
        if (it < N_DENSE) {
            const int l = it / (I_IN + I_OUT); int r = it % (I_IN + I_OUT);
            if (r < I_IN) { const int kb = r / 48, nb = r % 48; p0_transpose_item(F.in[6] + (size_t)l * D * INW, D, INW, (bf16*)(F.ws + WS_WIN) + (size_t)l * INW * D, kb, nb, 32 * nb, scr, F.lane); }
            else { r -= I_IN; const int kb = r / 32, nb = r % 32; p0_transpose_item(F.in[14] + (size_t)l * D * D, D, D, (bf16*)(F.ws + WS_WOUT) + (size_t)l * D * D, kb, nb, 32 * nb, scr, F.lane); }
        } else {
            const int m = it - N_DENSE; const int le = m / (3 * I_SQ); int r = m % (3 * I_SQ); const int which = r / I_SQ; r %= I_SQ; const int kb = r / 32, nb = r % 32;
            if (which == 2) p0_transpose_item(F.in[20] + (size_t)le * D * D, D, D, (bf16*)(F.ws + WS_W2) + (size_t)le * D * D, kb, nb, 32 * nb, scr, F.lane);
            else { const int n0 = 32 * nb; const int drow0 = (n0 >> 7) * 256 + (n0 & 127) + (which == 1 ? 128 : 0);
                p0_transpose_item((which == 0 ? F.in[18] : F.in[19]) + (size_t)le * D * D, D, D, (bf16*)(F.ws + WS_W13) + (size_t)le * 2 * D * D, kb, nb, drow0, scr, F.lane); }
        }
    }
}

__device__ __forceinline__ void p1_mod_rows(Frame& F) {
    frame_ids(F);
    const float* MOD = (const float*)(F.ws + WS_MOD); bf16* H = (bf16*)(F.ws + WS_H);
    const int gw = F.vcu * NWAVES + F.wave, NGW = F.G * NWAVES;
    for (int tok = gw; tok < TTOK; tok += NGW) {
        f32x4 v[4]; row_load(v, x_input_row(F, tok), F.lane); row_ln(v);
        const float* md = MOD + (size_t)tok_cond(tok) * MODW;
        const GAS f32x4* sh = (const GAS f32x4*)(md) + F.lane; const GAS f32x4* sc = (const GAS f32x4*)(md + D) + F.lane;
#pragma unroll
        for (int j = 0; j < 4; ++j) v[j] = v[j] * (sc[64 * j] + 1.0f) + sh[64 * j];
        row_store_bf16(v, H + (size_t)tok * D, F.lane);
    }
}

template <int HALFW> __device__ __forceinline__ void pool_diff(const bf16* Zc  , int pos0, int L, int tg, LAS bf16* dP, int c) {
    float v[31];
#pragma unroll
    for (int j = 0; j < 31; ++j) { const int rel = 16 * tg - 8 + j; const int pos = pos0 + rel; v[j] = (pos >= 0 && pos < L) ? bf1(Zc[(long)rel * INW]) : 0.f; }
    float s = 0.f;
#pragma unroll
    for (int j = 8 - HALFW; j < 8 + HALFW; ++j) s += v[j];
#pragma unroll
    for (int i = 0; i < 16; ++i) {
        const int pos = pos0 + 16 * tg + i; const int hi = (pos + HALFW < L) ? pos + HALFW : L, lo = (pos - HALFW > 0) ? pos - HALFW : 0;
        const float d = s / (float)(hi - lo) - v[i + 8];
        dP[(16 * tg + i) * 72 + c] = (bf16)f2bf(d);
        if (i < 15) s += v[i + 8 + HALFW] - v[i + 8 - HALFW];
    }
}
__device__ __forceinline__ void pc_item(Frame& F, int l, int ck, int qt, bool kv_only) {
    const bf16* Z = (const bf16*)(F.ws + WS_Z); bf16* MIX = (bf16*)(F.ws + WS_MIX);
    const int tok0 = ck * 128; const bool isctx = tok0 >= TLAT;
    const int b = isctx ? ((tok0 - TLAT) >> 8) : (tok0 >> 12);
    const int pos0 = isctx ? ((tok0 - TLAT) & 255) : (tok0 & 4095);
    const int L = isctx ? CTXL : SEQ;
    const int tid = F.tid, lane = F.lane, wave = F.wave;
    LAS bf16* vT = (LAS bf16*)(F.lds);
    LAS bf16* dP = (LAS bf16*)(F.lds + 17408);
    if (!kv_only) {
        { const int h = qt, p = tid >> 2, dq = tid & 3;
          const GAS v4u* src = (const GAS v4u*)(Z + (size_t)(tok0 + p) * INW + OFF_V + h * 64 + 16 * dq);
          const v4u w0 = src[0], w1 = src[1]; float x[16];
          x[0] = bflo(w0.x); x[1] = bfhi(w0.x); x[2] = bflo(w0.y); x[3] = bfhi(w0.y); x[4] = bflo(w0.z); x[5] = bfhi(w0.z); x[6] = bflo(w0.w); x[7] = bfhi(w0.w);
          x[8] = bflo(w1.x); x[9] = bfhi(w1.x); x[10] = bflo(w1.y); x[11] = bfhi(w1.y); x[12] = bflo(w1.z); x[13] = bfhi(w1.z); x[14] = bflo(w1.w); x[15] = bfhi(w1.w);
          float s = 0.f;
#pragma unroll
          for (int i = 0; i < 16; ++i) { x[i] = gelu_tanh(x[i]); s += x[i]; }
          s += __shfl_xor(s, 1); s += __shfl_xor(s, 2);
          const float mean = s * (1.f / 64.f); float s2 = 0.f;
#pragma unroll
          for (int i = 0; i < 16; ++i) { x[i] -= mean; s2 += x[i] * x[i]; }
          s2 += __shfl_xor(s2, 1); s2 += __shfl_xor(s2, 2);
          const float rstd = 1.f / sqrtf(s2 * (1.f / 64.f) + LN_EPS);
          const float* gg = F.in[9] + ((size_t)l * 4 + h) * 64 + 16 * dq;
#pragma unroll
          for (int i = 0; i < 16; ++i) vT[(16 * dq + i) * 136 + p] = (bf16)f2bf(x[i] * rstd * gg[i]); }
        { const int g = qt, c = tid & 63, tg = tid >> 6; const bf16* Zc = Z + (size_t)tok0 * INW + OFF_POOL + g * 64 + c;
          if (g == 0) pool_diff<1>(Zc, pos0, L, tg, dP, c); else if (g == 1) pool_diff<2>(Zc, pos0, L, tg, dP, c); else if (g == 2) pool_diff<4>(Zc, pos0, L, tg, dP, c); else pool_diff<8>(Zc, pos0, L, tg, dP, c); }
        __syncthreads();
        { const int h = qt, fr = lane & 15, fq = lane >> 4, p = 16 * wave + fr;
          const bf16* SGUW = (const bf16*)(F.ws + WS_SGUW) + (((size_t)l * 4 + h) * 128 + p) * 128 + 8 * fq;
          bf16x8 wf[4];
#pragma unroll
          for (int ks = 0; ks < 4; ++ks) wf[ks] = *(const GAS bf16x8*)(SGUW + 32 * ks);
          f32x4 acc[4];
#pragma unroll
          for (int db = 0; db < 4; ++db) { acc[db] = (f32x4){0.f, 0.f, 0.f, 0.f};
#pragma unroll
              for (int ks = 0; ks < 4; ++ks) { const bf16x8 vf = *(const LAS bf16x8*)(vT + (16 * db + fr) * 136 + 32 * ks + 8 * fq);
                  acc[db] = __builtin_amdgcn_mfma_f32_16x16x32_bf16(vf, wf[ks], acc[db], 0, 0, 0); } }
          const float bias = F.in[11][((size_t)l * 4 + h) * 128 + p];
#pragma unroll
          for (int db = 0; db < 4; ++db) { const int d0 = 16 * db + 4 * fq;
              const v2u uw = *(const GAS v2u*)(Z + (size_t)(tok0 + p) * INW + OFF_U + h * 64 + d0);
              const float o0 = gelu_tanh(bflo(uw.x)) * (acc[db][0] + bias), o1 = gelu_tanh(bfhi(uw.x)) * (acc[db][1] + bias), o2 = gelu_tanh(bflo(uw.y)) * (acc[db][2] + bias), o3 = gelu_tanh(bfhi(uw.y)) * (acc[db][3] + bias);
              v2u ow; ow.x = pk2(o0, o1); ow.y = pk2(o2, o3);
              *(GAS v2u*)(MIX + (size_t)(tok0 + p) * D + 256 + h * 64 + d0) = ow; } }
        { const int g = qt, fr = lane & 15, fq = lane >> 4, p = 16 * wave + fr;
          const bf16* PWT = (const bf16*)(F.ws + WS_PWT) + ((size_t)l * 4 + g) * 4096;
          bf16x8 df[2];
#pragma unroll
          for (int ks = 0; ks < 2; ++ks) df[ks] = *(const LAS bf16x8*)(dP + p * 72 + 32 * ks + 8 * fq);
#pragma unroll
          for (int jb = 0; jb < 4; ++jb) { f32x4 acc = (f32x4){0.f, 0.f, 0.f, 0.f};
#pragma unroll
              for (int ks = 0; ks < 2; ++ks) { const bf16x8 pf = *(const GAS bf16x8*)(PWT + (16 * jb + fr) * 64 + 32 * ks + 8 * fq);
                  acc = __builtin_amdgcn_mfma_f32_16x16x32_bf16(pf, df[ks], acc, 0, 0, 0); }
              const int j0 = 16 * jb + 4 * fq; const f32x4 sc = *(const GAS f32x4*)(F.in[8] + (size_t)l * 256 + g * 64 + j0);
              v2u ow; ow.x = pk2(acc[0] * sc.x, acc[1] * sc.y); ow.y = pk2(acc[2] * sc.z, acc[3] * sc.w);
              *(GAS v2u*)(MIX + (size_t)(tok0 + p) * D + g * 64 + j0) = ow; } }
    }
    { bf16* Q = (bf16*)(F.ws + WS_Q); bf16* KB = (bf16*)(F.ws + WS_K); bf16* VB = (bf16*)(F.ws + WS_V);
      const float* COS = (const float*)(F.ws + WS_COS); const float* SIN = (const float*)(F.ws + WS_SIN);
      const int tt = (tid & 255) >> 3, sub = tid & 7; const int tok = tok0 + 32 * qt + tt; const int pos = pos0 + 32 * qt + tt;
      const size_t kvrow = (size_t)b * KVROWS + (isctx ? SEQ + pos : pos);
      f32x4 cs0 = (f32x4){1.f, 1.f, 1.f, 1.f}, cs1 = cs0, sn0 = (f32x4){0.f, 0.f, 0.f, 0.f}, sn1 = sn0;
      if (!isctx) { const GAS f32x4* cp = (const GAS f32x4*)(COS + (size_t)pos * 32 + 8 * (sub & 3)); const GAS f32x4* sp = (const GAS f32x4*)(SIN + (size_t)pos * 32 + 8 * (sub & 3));
          cs0 = cp[0]; cs1 = cp[1]; sn0 = sp[0]; sn1 = sp[1]; }
      const float cs[8] = {cs0.x, cs0.y, cs0.z, cs0.w, cs1.x, cs1.y, cs1.z, cs1.w}; const float sn[8] = {sn0.x, sn0.y, sn0.z, sn0.w, sn1.x, sn1.y, sn1.z, sn1.w};
#pragma unroll 1
      for (int ps = (kv_only ? 4 : 0); ps < 5; ++ps) {
          const int hs = 2 * ps + (tid >> 8);
          const bool isq = hs < 8;
          const int col = (isq ? OFF_Q + hs * 64 : OFF_K + (hs - 8) * 64) + 8 * sub;
          const v4u w = *(const GAS v4u*)(Z + (size_t)tok * INW + col);
          float x[8] = {bflo(w.x), bfhi(w.x), bflo(w.y), bfhi(w.y), bflo(w.z), bfhi(w.z), bflo(w.w), bfhi(w.w)};
          float ss = 0.f;
#pragma unroll
          for (int e = 0; e < 8; ++e) ss += x[e] * x[e];
          ss += __shfl_xor(ss, 1); ss += __shfl_xor(ss, 2); ss += __shfl_xor(ss, 4);
          const float r = 1.f / sqrtf(ss * (1.f / 64.f) + LN_EPS);
          const float* gp = (isq ? F.in[12] : F.in[13]) + (size_t)l * 64 + 8 * sub;
          float y[8], o[8];
#pragma unroll
          for (int e = 0; e < 8; ++e) y[e] = x[e] * r * gp[e];
#pragma unroll
          for (int e = 0; e < 8; ++e) { const float pr = __shfl_xor(y[e], 4); o[e] = (sub < 4) ? (y[e] * cs[e] - pr * sn[e]) : (y[e] * cs[e] + pr * sn[e]); }
          if (isq) {
#pragma unroll
              for (int e = 0; e < 8; ++e) o[e] *= 0.18033688011112042f;
          }
          v4u ow; ow.x = pk2(o[0], o[1]); ow.y = pk2(o[2], o[3]); ow.z = pk2(o[4], o[5]); ow.w = pk2(o[6], o[7]);
          if (isq) *(GAS v4u*)(Q + (size_t)tok * 512 + hs * 64 + 8 * sub) = ow;
          else *(GAS v4u*)(KB + kvrow * 128 + (hs - 8) * 64 + 8 * sub) = ow;
      }
      { const int t2 = tid >> 4, part = tid & 15; const int tk = tok0 + 32 * qt + t2; const int ps2 = pos0 + 32 * qt + t2;
        const size_t kr = (size_t)b * KVROWS + (isctx ? SEQ + ps2 : ps2);
        *(GAS v4u*)(VB + kr * 128 + 8 * part) = *(const GAS v4u*)(Z + (size_t)tk * INW + OFF_VAL + 8 * part); }
    }
    __syncthreads();
}

__device__ __forceinline__ void pf_rows(Frame& F, int l, bool last) {
    frame_ids(F);
    const float* MOD = (const float*)(F.ws + WS_MOD) + (size_t)l * NCOND * MODW;
    float* XB = (float*)(F.ws + WS_X); bf16* H = (bf16*)(F.ws + WS_H); const bf16* Y = (const bf16*)(F.ws + WS_Y); float* AFF = (float*)(F.ws + WS_AFF);
    LAS float* wrT = (LAS float*)(F.lds);
    { const float* wr = F.in[17] + (size_t)l * D * NEXP;
      for (int i = F.tid; i < D * NEXP; i += NWAVES * 64) { const int k = i >> 4, e = i & 15; wrT[e * D + k] = wr[i]; } }
    __syncthreads();
    const int gw = F.vcu * NWAVES + F.wave, NGW = F.G * NWAVES; const int ntok = last ? TLAT : TTOK;
    const int R = (ntok + NGW - 1) / NGW; const int r0 = gw * R; const int r1 = (r0 + R < ntok) ? r0 + R : ntok;
    if (r0 < r1) {
        f32x4 lg[4], lb[4];
        { const GAS f32x4* g1p = (const GAS f32x4*)(F.in[15] + (size_t)l * D) + F.lane; const GAS f32x4* b1p = (const GAS f32x4*)(F.in[16] + (size_t)l * D) + F.lane;
#pragma unroll
          for (int j = 0; j < 4; ++j) { lg[j] = g1p[64 * j]; lb[j] = b1p[64 * j]; } }
        f32x4 xv[4]; v2u yv[4];
        { const GAS f32x4* xr = (const GAS f32x4*)(l == 0 ? x_input_row(F, r0) : XB + (size_t)r0 * D) + F.lane; const GAS v2u* yr = (const GAS v2u*)(Y + (size_t)r0 * D) + F.lane;
#pragma unroll
          for (int j = 0; j < 4; ++j) { xv[j] = xr[64 * j]; yv[j] = yr[64 * j]; } }
        int cond = -1; f32x4 g1[4], sh2[4], sc2[4];
#pragma unroll
        for (int j = 0; j < 4; ++j) { g1[j] = (f32x4){0.f, 0.f, 0.f, 0.f}; sh2[j] = g1[j]; sc2[j] = g1[j]; }
#pragma unroll 1
        for (int tok = r0; tok < r1; ++tok) {
            const int tn = (tok + 1 < r1) ? tok + 1 : tok;
            f32x4 nx[4]; v2u ny[4];
            { const GAS f32x4* xr = (const GAS f32x4*)(l == 0 ? x_input_row(F, tn) : XB + (size_t)tn * D) + F.lane; const GAS v2u* yr = (const GAS v2u*)(Y + (size_t)tn * D) + F.lane;
#pragma unroll
              for (int j = 0; j < 4; ++j) { nx[j] = xr[64 * j]; ny[j] = yr[64 * j]; } }
            const int c = tok_cond(tok);
            if (c != cond) { cond = c; const float* md = MOD + (size_t)c * MODW;
                const GAS f32x4* gp = (const GAS f32x4*)(md + 2 * D) + F.lane; const GAS f32x4* sh = (const GAS f32x4*)(md + 3 * D) + F.lane; const GAS f32x4* sc = (const GAS f32x4*)(md + 4 * D) + F.lane;
#pragma unroll
                for (int j = 0; j < 4; ++j) { g1[j] = gp[64 * j]; sh2[j] = sh[64 * j]; sc2[j] = sc[64 * j] + 1.0f; } }
            f32x4 v[4];
#pragma unroll
            for (int j = 0; j < 4; ++j) { const f32x4 y = (f32x4){bflo(yv[j].x), bfhi(yv[j].x), bflo(yv[j].y), bfhi(yv[j].y)}; v[j] = xv[j] * DN_ALPHA + g1[j] * y; }
            row_ln(v);
#pragma unroll
            for (int j = 0; j < 4; ++j) v[j] = v[j] * lg[j] + lb[j];
            row_store(v, XB + (size_t)tok * D, F.lane);
            row_ln(v);
#pragma unroll
            for (int j = 0; j < 4; ++j) v[j] = v[j] * sc2[j] + sh2[j];
            row_store_bf16(v, H + (size_t)tok * D, F.lane);
            float lgm = -3.0e38f;
#pragma unroll 1
            for (int e = 0; e < NEXP; ++e) { float a = 0.f;
#pragma unroll
                for (int j = 0; j < 4; ++j) { const f32x4 w = *(const LAS f32x4*)(wrT + e * D + 256 * j + 4 * F.lane); a += (v[j].x * w.x + v[j].y * w.y) + (v[j].z * w.z + v[j].w * w.w); }
                a = wave_sum(a); lgm = (F.lane == e) ? a : lgm; }
            float mx = lgm;
            mx = fmaxf(mx, dppmov<0xB1>(mx)); mx = fmaxf(mx, dppmov<0x4E>(mx)); mx = fmaxf(mx, dppmov<0x141>(mx)); mx = fmaxf(mx, dppmov<0x140>(mx));
            const float ex = (F.lane < NEXP) ? expf(lgm - mx) : 0.f; float sum = ex;
            sum += dppmov<0xB1>(sum); sum += dppmov<0x4E>(sum); sum += dppmov<0x141>(sum); sum += dppmov<0x140>(sum);
            if (F.lane < NEXP) AFF[(size_t)tok * NEXP + F.lane] = ex / sum;
#pragma unroll
            for (int j = 0; j < 4; ++j) { xv[j] = nx[j]; yv[j] = ny[j]; }
        }
    }
    __syncthreads();
}

__device__ __forceinline__ void pg_item(Frame& F, int s, int e) {
    const float* AFF = (const float*)(F.ws + WS_AFF); int* ROWIDX = (int*)(F.ws + WS_ROWIDX); float* GATE = (float*)(F.ws + WS_GATE); int* INV = (int*)(F.ws + WS_INV);
    const bool isctx = s >= NBATCH; const int n = isctx ? CTXL : SEQ, cap = isctx ? CAP_C : CAP_L;
    const int tok0 = isctx ? TLAT + (s - NBATCH) * CTXL : s * SEQ;
    const int sbase = isctx ? NBATCH * CAP_L + (s - NBATCH) * CAP_C : s * CAP_L;
    LAS unsigned* hist = (LAS unsigned*)(F.lds);
    LAS unsigned* sel = (LAS unsigned*)(F.lds + 1024);
    LAS unsigned* wtot = (LAS unsigned*)(F.lds + 1088);
    const int tid = F.tid, lane = F.lane;
    unsigned bits[8];
#pragma unroll
    for (int i = 0; i < 8; ++i) { const int idx = 8 * tid + i; bits[i] = idx < n ? __builtin_bit_cast(unsigned, AFF[(size_t)(tok0 + idx) * NEXP + e]) : 0u; }
    unsigned prefix = 0u, krem = (unsigned)cap;
#pragma unroll 1
    for (int pass = 0; pass < 4; ++pass) {
        const int shift = 24 - 8 * pass;
        if (tid < 256) hist[tid] = 0u;
        __syncthreads();
#pragma unroll
        for (int i = 0; i < 8; ++i) { const bool valid = (8 * tid + i) < n; const bool match = (pass == 0) ? true : ((bits[i] >> (shift + 8)) == prefix);
            if (valid && match) __hip_atomic_fetch_add(&hist[(bits[i] >> shift) & 255u], 1u, __ATOMIC_RELAXED, __HIP_MEMORY_SCOPE_WORKGROUP); }
        __syncthreads();
        if (tid < 64) {
            unsigned c[4]; unsigned tot = 0u;
#pragma unroll
            for (int j = 0; j < 4; ++j) { c[j] = hist[255 - 4 * lane - j]; tot += c[j]; }
            unsigned incl = tot;
#pragma unroll
            for (int o = 1; o < 64; o <<= 1) { const unsigned t = __shfl_up(incl, o); if (lane >= o) incl += t; }
            unsigned run = incl - tot;
#pragma unroll
            for (int j = 0; j < 4; ++j) { if (run < krem && run + c[j] >= krem) { sel[0] = (unsigned)(255 - 4 * lane - j); sel[1] = krem - run; } run += c[j]; }
        }
        __syncthreads();
        prefix = (prefix << 8) | sel[0]; krem = sel[1];
        __syncthreads();
    }
    const unsigned thr = prefix;
    unsigned loc = 0u;
#pragma unroll
    for (int i = 0; i < 8; ++i) { const bool valid = (8 * tid + i) < n; loc += (valid && bits[i] > thr) ? 1u : 0u; loc += (valid && bits[i] == thr) ? 0x10000u : 0u; }
    unsigned incl = loc;
#pragma unroll
    for (int o = 1; o < 64; o <<= 1) { const unsigned t = __shfl_up(incl, o); if (lane >= o) incl += t; }
    if (lane == 63) wtot[F.wave] = incl;
    __syncthreads();
    unsigned before = incl - loc;
#pragma unroll
    for (int w = 0; w < NWAVES; ++w) before += (w < F.wave) ? wtot[w] : 0u;
#pragma unroll
    for (int i = 0; i < 8; ++i) { const int idx = 8 * tid + i;
        if (idx < n) { const unsigned g = before & 0xffffu, q = before >> 16; const bool gt = bits[i] > thr, eq = bits[i] == thr;
            int slot = -1;
            if (gt) slot = (int)(g + (q < krem ? q : krem)); else if (eq && q < krem) slot = (int)(g + q);
            const int tok = tok0 + idx;
            if (slot >= 0) { ROWIDX[(size_t)e * EROWS + sbase + slot] = tok; GATE[(size_t)e * EROWS + sbase + slot] = __builtin_bit_cast(float, bits[i]); }
            INV[(size_t)tok * NEXP + e] = slot >= 0 ? sbase + slot : -1;
            before += gt ? 1u : 0u; before += eq ? 0x10000u : 0u; } }
    __syncthreads();
}

__device__ __forceinline__ void pj_rows(Frame& F, int l, bool last) {
    frame_ids(F);
    const float* MOD = (const float*)(F.ws + WS_MOD) + (size_t)l * NCOND * MODW;
    float* XB = (float*)(F.ws + WS_X); bf16* H = (bf16*)(F.ws + WS_H); const bf16* YE = (const bf16*)(F.ws + WS_YEXP); const int* INV = (const int*)(F.ws + WS_INV);
    const int gw = F.vcu * NWAVES + F.wave, NGW = F.G * NWAVES; const int ntok = last ? TLAT : TTOK;
    const int R = (ntok + NGW - 1) / NGW; const int r0 = gw * R; const int r1 = (r0 + R < ntok) ? r0 + R : ntok;
    if (r0 < r1) {
        f32x4 lg[4], lb[4];
        { const GAS f32x4* g2p = (const GAS f32x4*)(F.in[21] + (size_t)l * D) + F.lane; const GAS f32x4* b2p = (const GAS f32x4*)(F.in[22] + (size_t)l * D) + F.lane;
#pragma unroll
          for (int j = 0; j < 4; ++j) { lg[j] = g2p[64 * j]; lb[j] = b2p[64 * j]; } }
        f32x4 xv[4]; int invv = INV[(size_t)r0 * NEXP + (F.lane & 15)];
        row_load(xv, XB + (size_t)r0 * D, F.lane);
        int cond = -1; f32x4 g2[4], sh1[4], sc1[4];
#pragma unroll
        for (int j = 0; j < 4; ++j) { g2[j] = (f32x4){0.f, 0.f, 0.f, 0.f}; sh1[j] = g2[j]; sc1[j] = g2[j]; }
#pragma unroll 1
        for (int tok = r0; tok < r1; ++tok) {
            const int tn = (tok + 1 < r1) ? tok + 1 : tok;
            f32x4 nx[4]; row_load(nx, XB + (size_t)tn * D, F.lane); const int ninv = INV[(size_t)tn * NEXP + (F.lane & 15)];
            const int c = tok_cond(tok);
            if (c != cond) { cond = c; const float* md = MOD + (size_t)c * MODW; const float* mdn = md + (size_t)NCOND * MODW;
                const GAS f32x4* gp = (const GAS f32x4*)(md + 5 * D) + F.lane;
#pragma unroll
                for (int j = 0; j < 4; ++j) g2[j] = gp[64 * j];
                if (!last) { const GAS f32x4* sh = (const GAS f32x4*)(mdn) + F.lane; const GAS f32x4* sc = (const GAS f32x4*)(mdn + D) + F.lane;
#pragma unroll
                    for (int j = 0; j < 4; ++j) { sh1[j] = sh[64 * j]; sc1[j] = sc[64 * j] + 1.0f; } } }
            f32x4 ml[4];
#pragma unroll
            for (int j = 0; j < 4; ++j) ml[j] = (f32x4){0.f, 0.f, 0.f, 0.f};
            unsigned mask = (unsigned)__builtin_amdgcn_ballot_w64(F.lane < NEXP && invv >= 0);
            while (mask) {
                const int e0 = __builtin_ctz(mask); mask &= mask - 1u; const bool two = mask != 0u; const int e1 = two ? __builtin_ctz(mask) : e0; if (two) mask &= mask - 1u;
                const int s0 = __builtin_amdgcn_readlane(invv, e0), s1 = __builtin_amdgcn_readlane(invv, e1);
                const GAS v2u* p0 = (const GAS v2u*)(YE + ((size_t)e0 * EROWS + s0) * D) + F.lane; const GAS v2u* p1 = (const GAS v2u*)(YE + ((size_t)e1 * EROWS + s1) * D) + F.lane;
                v2u a[4], b[4];
#pragma unroll
                for (int j = 0; j < 4; ++j) { a[j] = p0[64 * j]; b[j] = p1[64 * j]; }
#pragma unroll
                for (int j = 0; j < 4; ++j) { ml[j] = ml[j] + (f32x4){bflo(a[j].x), bfhi(a[j].x), bflo(a[j].y), bfhi(a[j].y)};
                    if (two) ml[j] = ml[j] + (f32x4){bflo(b[j].x), bfhi(b[j].x), bflo(b[j].y), bfhi(b[j].y)}; }
            }
            f32x4 v[4];
#pragma unroll
            for (int j = 0; j < 4; ++j) v[j] = xv[j] * DN_ALPHA + g2[j] * ml[j];
            row_ln(v);
#pragma unroll
            for (int j = 0; j < 4; ++j) v[j] = v[j] * lg[j] + lb[j];
            if (last) { row_store(v, F.out + (size_t)tok * D, F.lane); }
            else {
                row_store(v, XB + (size_t)tok * D, F.lane);
                row_ln(v);
#pragma unroll
                for (int j = 0; j < 4; ++j) v[j] = v[j] * sc1[j] + sh1[j];
                row_store_bf16(v, H + (size_t)tok * D, F.lane);
            }
#pragma unroll
            for (int j = 0; j < 4; ++j) xv[j] = nx[j];
            invv = ninv;
        }
    }
}

constexpr int NPHASE = 2 + 9 * DEPTH;
#ifndef REP_P0
#define REP_P0 1
#endif
#ifndef REP_GEMM
#define REP_GEMM 1
#endif
#ifndef REP_PD
#define REP_PD 1
#endif
#ifndef REP_PC
#define REP_PC 1
#endif
#ifndef REP_PG
#define REP_PG 1
#endif
#define REPEAT(n) _Pragma("unroll") for (int rep_ = 0; rep_ < (n); ++rep_)
__global__ void __launch_bounds__(NWAVES * 64, 2) fwd_kernel(Args args) {
    extern __shared__ __attribute__((aligned(16))) unsigned char lds[];
    Frame F;
    F.lds = (LAS unsigned char*)lds;
    F.tid = threadIdx.x; F.lane = F.tid & 63; F.wave = __builtin_amdgcn_readfirstlane(F.tid >> 6);
    F.G = gridDim.x; { const int bx = blockIdx.x; F.vcu = (F.G % 8 == 0) ? (bx % 8) * (F.G / 8) + bx / 8 : bx; }
    F.in = args.in; F.out = args.out; F.ws = args.ws;
    volatile LAS unsigned* MISC = (volatile LAS unsigned*)(F.lds + MISC_OFF);
    for (int u = F.tid; u < (LDS_BYTES - LDSCTL_OFF) / 4; u += NWAVES * 64) ((LAS unsigned*)(F.lds + LDSCTL_OFF))[u] = 0u;
    __syncthreads();
    XcdBarrier bar; bar.bar = (unsigned*)(args.ws + WS_CTL) + CW_BAR; bar.x = 0; bar.st = nullptr;
#if !MK_PER_PHASE
    bar = xcd_barrier_post((unsigned*)(args.ws + WS_CTL) + CW_BAR, MISC + 8);
#endif
    const int lo = args.ph_lo, hi = args.ph_hi;
#define IN(k) (lo <= (k) && (k) < hi)
#if MK_PER_PHASE
#define SEAM(k) do { } while (0)
#else
#define SEAM(k) do { if (IN((k) + 1)) xcd_barrier(bar); } while (0)
#endif
    if (IN(0)) { REPEAT(REP_P0) { p0_prologue(F); __syncthreads(); } SEAM(0); }
    if (IN(1)) { p1_mod_rows(F); SEAM(1); }
#pragma unroll 1
    for (int l = 0; l < DEPTH; ++l) {
        const int pb = 2 + 9 * l; const bool last = (l == DEPTH - 1);
        if (IN(pb + 0)) {
            pg8::DenseOrder S; S.A = (const bf16*)(F.ws + WS_H); S.Bt = (const bf16*)(F.ws + WS_WIN) + (size_t)l * INW * D; S.K = D; S.nN = INW / 256; S.G = F.G; S.c = (int)blockIdx.x;
            if (last) { S.nM = TLAT / 256; S.extra_pm0 = TLAT / 256; S.n_extra = TCTX / 256; S.extra_pn = 5; } else { S.nM = TTOK / 256; S.extra_pm0 = 0; S.n_extra = 0; S.extra_pn = 0; }
            S.nwg = S.nM * S.nN;
            pg8::EpiBf16Plain E{(bf16*)(F.ws + WS_Z), INW};
            REPEAT(REP_GEMM) { pg8::gemm_phase<pg8::EpiBf16Plain, pg8::DenseOrder, true>(F.lds + RING_OFF, S, E); }
            SEAM(pb + 0);
        }
        if (IN(pb + 1)) {
            frame_ids(F);
            const int nlat = (TLAT / 128) * 4, nall = (TTOK / 128) * 4;
            REPEAT(REP_PC) { for (int it = F.vcu; it < nall; it += F.G) pc_item(F, l, it >> 2, it & 3, last && it >= nlat); }
            SEAM(pb + 1);
        }
        if (IN(pb + 2)) {
            const attn_body::bf16* Q = (const attn_body::bf16*)(F.ws + WS_Q); const attn_body::bf16* KB = (const attn_body::bf16*)(F.ws + WS_K); const attn_body::bf16* VB = (const attn_body::bf16*)(F.ws + WS_V);
            attn_body::bf16* MIX = (attn_body::bf16*)(F.ws + WS_MIX);
            const int nun = last ? 1024 : 1024 + 64;
            REPEAT(REP_PD) for (int L = F.vcu; L < nun; L += F.G) {
                if (L < 1024) { const int i = L >> 8, v = L & 255, x = v >> 5, j = v & 31; const int b = x, kvh = i >> 1, h = kvh * 4 + (j & 3), qb = (i & 1) * 8 + (j >> 2);
                    attn_body::attn_unit<8>(Q + ((size_t)b * SEQ + qb * 256) * 512 + h * 64, KB + (size_t)b * KVROWS * 128 + kvh * 64, VB + (size_t)b * KVROWS * 128 + kvh * 64,
                                            MIX + ((size_t)b * SEQ + qb * 256) * D + 512 + h * 64, KVROWS / 64, (char*)lds + RING_OFF); }
                else { const int c = L - 1024, b = c >> 3, h = c & 7, kvh = h >> 2;
                    attn_body::attn_unit<8>(Q + ((size_t)TLAT + b * CTXL) * 512 + h * 64, KB + ((size_t)b * KVROWS + SEQ) * 128 + kvh * 64, VB + ((size_t)b * KVROWS + SEQ) * 128 + kvh * 64,
                                            MIX + ((size_t)TLAT + b * CTXL) * D + 512 + h * 64, CTXL / 64, (char*)lds + RING_OFF); }
            }
            SEAM(pb + 2);
        }
        if (IN(pb + 3)) {
            pg8::DenseOrder S; S.A = (const bf16*)(F.ws + WS_MIX); S.Bt = (const bf16*)(F.ws + WS_WOUT) + (size_t)l * D * D; S.K = D; S.nN = D / 256; S.G = F.G; S.c = (int)blockIdx.x;
            S.nM = (last ? TLAT : TTOK) / 256; S.extra_pm0 = 0; S.n_extra = 0; S.extra_pn = 0; S.nwg = S.nM * S.nN;
            pg8::EpiBf16Plain E{(bf16*)(F.ws + WS_Y), D};
            REPEAT(REP_GEMM) { pg8::gemm_phase<pg8::EpiBf16Plain, pg8::DenseOrder, true>(F.lds + RING_OFF, S, E); }
            SEAM(pb + 3);
        }
        if (IN(pb + 4)) { pf_rows(F, l, last); SEAM(pb + 4); }
        if (IN(pb + 5)) {
            frame_ids(F);
            const int nit = (last ? NBATCH : 2 * NBATCH) * NEXP;
            REPEAT(REP_PG) { for (int it = F.vcu; it < nit; it += F.G) pg_item(F, it >> 4, it & 15); }
            SEAM(pb + 5);
        }
        if (IN(pb + 6)) {
            pg8::MoeOrder<true> S; S.A = (const bf16*)(F.ws + WS_H); S.Bt = (const bf16*)(F.ws + WS_W13) + (size_t)l * NEXP * 2 * D * D; S.rowidx = (const int*)(F.ws + WS_ROWIDX);
            S.K = D; S.nRT = last ? 16 : 17; S.nPN = 8; S.ERP = EROWS; S.BRP = 2 * D; S.nwg = NEXP * S.nRT * S.nPN; S.G = F.G; S.c = (int)blockIdx.x;
            pg8::EpiSwiglu E{(bf16*)(F.ws + WS_HID), EROWS};
            REPEAT(REP_GEMM) { pg8::gemm_phase<pg8::EpiSwiglu, pg8::MoeOrder<true>, true>(F.lds + RING_OFF, S, E); }
            SEAM(pb + 6);
        }
        if (IN(pb + 7)) {
            pg8::MoeOrder<false> S; S.A = (const bf16*)(F.ws + WS_HID); S.Bt = (const bf16*)(F.ws + WS_W2) + (size_t)l * NEXP * D * D; S.rowidx = nullptr;
            S.K = D; S.nRT = last ? 16 : 17; S.nPN = 4; S.ERP = EROWS; S.BRP = D; S.nwg = NEXP * S.nRT * S.nPN; S.G = F.G; S.c = (int)blockIdx.x;
            pg8::EpiGate E{(bf16*)(F.ws + WS_YEXP), (const float*)(F.ws + WS_GATE), EROWS};
            REPEAT(REP_GEMM) { pg8::gemm_phase<pg8::EpiGate, pg8::MoeOrder<false>, true>(F.lds + RING_OFF, S, E); }
            SEAM(pb + 7);
        }
        if (IN(pb + 8)) { pj_rows(F, l, last); if (!last) SEAM(pb + 8); }
    }
#undef IN
#undef SEAM
}

extern "C" void kernel_launch(void* const* d_in, const int* in_sizes, int n_in, void* d_out, int out_size, void* d_ws, size_t ws_size, hipStream_t stream) {
    static int grid = 0;
    if (grid == 0) {
        if (n_in != 23 || in_sizes[0] != TLAT * D || out_size != TLAT * D || ws_size < WS_END) { fprintf(stderr, "kernel_launch: unexpected shapes / workspace (n_in %d, ws %zu); nothing launched\n", n_in, ws_size); grid = -1; return; }
        int dev = 0, cus = 0, per_cu = 0;
        if (hipGetDevice(&dev) != hipSuccess || hipDeviceGetAttribute(&cus, hipDeviceAttributeMultiprocessorCount, dev) != hipSuccess) { grid = -1; return; }
        if (hipFuncSetAttribute((const void*)fwd_kernel, hipFuncAttributeMaxDynamicSharedMemorySize, LDS_BYTES) != hipSuccess) { fprintf(stderr, "kernel_launch: hipFuncSetAttribute failed\n"); grid = -1; return; }
        if (hipOccupancyMaxActiveBlocksPerMultiprocessor(&per_cu, (const void*)fwd_kernel, NWAVES * 64, LDS_BYTES) != hipSuccess || per_cu < 1) { fprintf(stderr, "kernel_launch: occupancy query says %d\n", per_cu); }
        (void)hipGetLastError();
        grid = cus;
    }
    if (grid < 0) return;
    if (hipMemsetAsync((char*)d_ws + WS_CTL, 0, CTL_ZERO_BYTES, stream) != hipSuccess) return;
    Args a{};
    for (int i = 0; i < 23; ++i) a.in[i] = (const float*)d_in[i];
    a.out = (float*)d_out; a.ws = (unsigned char*)d_ws;
#if MK_PER_PHASE
    for (int p = 0; p < NPHASE; ++p) { a.ph_lo = p; a.ph_hi = p + 1; hipLaunchKernelGGL(fwd_kernel, dim3(grid), dim3(NWAVES * 64), LDS_BYTES, stream, a); }
#else
    a.ph_lo = 0; a.ph_hi = NPHASE; hipLaunchKernelGGL(fwd_kernel, dim3(grid), dim3(NWAVES * 64), LDS_BYTES, stream, a);
#endif
}
```
